# Optimizing an MI355X kernel written in HIP

```python
import jax, jax.numpy as jnp
from jax import lax
import numpy as np

D_MODEL = 1024
BATCH = 32
SEQ = 2048
DEPTH = 4

N_MIXERS = 2
EPS = 1e-6
POOL_WINDOWS = (2, 4, 8, 16)
N_POOL_GROUPS = len(POOL_WINDOWS)
POOL_GROUP = D_MODEL // N_POOL_GROUPS
GLA_HEADS = 4
GLA_KEY_DIM = D_MODEL // 2
GLA_VAL_DIM = D_MODEL
GLA_DK = GLA_KEY_DIM // GLA_HEADS
GLA_DV = GLA_VAL_DIM // GLA_HEADS
GATE_RANK = 16
GATE_NORMALIZER = 16.0
CHUNK = 64
GLA_IN = 2 * GLA_KEY_DIM + 2 * GLA_VAL_DIM + 2 * GATE_RANK
D_FF = -(-8 * D_MODEL // (3 * 256)) * 256
N_POOL_LAYERS = (DEPTH + 1) // 2
N_GLA_LAYERS = DEPTH // 2

kernel_name = "hybrid_pool_gla_encoder"


def rms_norm(x, gain):
    xf = x.astype(jnp.float32)
    y = xf * lax.rsqrt(jnp.mean(xf * xf, axis=-1, keepdims=True) + EPS)
    return (y * gain.astype(jnp.float32)).astype(x.dtype)


def pool_mixer(h, w_group, scale):
    B, S, D = h.shape
    hf = h.astype(jnp.float32)
    csum = jnp.concatenate([jnp.zeros((B, 1, D), jnp.float32), jnp.cumsum(hf, axis=1)], axis=1)
    t = jnp.arange(S)
    outs = []
    for g, win in enumerate(POOL_WINDOWS):
        left = win // 2
        right = win - 1 - left
        lo = jnp.clip(t - left, 0, S)
        hi = jnp.clip(t + right + 1, 0, S)
        cs = csum[:, :, g * POOL_GROUP:(g + 1) * POOL_GROUP]
        cnt = (hi - lo).astype(jnp.float32)[None, :, None]
        mean = (jnp.take(cs, hi, axis=1) - jnp.take(cs, lo, axis=1)) / cnt
        outs.append(mean - hf[:, :, g * POOL_GROUP:(g + 1) * POOL_GROUP])
    mixed = jnp.stack(outs, axis=2).astype(h.dtype)
    y = jnp.einsum('bsgc,gcd->bsgd', mixed, w_group).reshape(B, S, D)
    return y * scale.astype(y.dtype)


def gla_chunked(q, k, v, log_a, strict):
    B, S, H, _ = q.shape
    n = S // CHUNK

    def blocks(a):
        return a.astype(jnp.float32).reshape(B, n, CHUNK, H, -1).transpose(1, 0, 3, 2, 4)

    qb, kb, vb, gb = blocks(q), blocks(k), blocks(v), blocks(log_a)
    b = jnp.cumsum(gb, axis=-2)
    b_last = b[..., -1:, :]
    q_dec = qb * jnp.exp(b)
    k_inv = kb * jnp.exp(-b)
    k_dec = kb * jnp.exp(b_last - b)
    mask = jnp.tril(jnp.ones((CHUNK, CHUNK), bool), k=-1 if strict else 0)
    scores = jnp.where(mask, jnp.einsum('nbhcd,nbhsd->nbhcs', q_dec, k_inv), 0.0)
    o_intra = jnp.einsum('nbhcs,nbhsv->nbhcv', scores, vb)

    def step(state, xs):
        qd, kd, vv, bl = xs
        o = jnp.einsum('bhcd,bhdv->bhcv', qd, state)
        state = jnp.exp(bl)[..., 0, :, None] * state + jnp.einsum('bhcd,bhcv->bhdv', kd, vv)
        return state, o

    s0 = jnp.zeros((B, H, qb.shape[-1], vb.shape[-1]), jnp.float32)
    _, o_inter = lax.scan(step, s0, (q_dec, k_dec, vb, b_last))
    o = o_intra + o_inter
    return o.transpose(1, 0, 3, 2, 4).reshape(B, S, H, vb.shape[-1])


def gla_mixer(h, w_in, w_gate_up, b_gate, head_gain, w_out):
    B, S, D = h.shape
    proj = h @ w_in
    i1 = GLA_KEY_DIM
    i2 = i1 + GLA_KEY_DIM
    i3 = i2 + GLA_VAL_DIM
    i4 = i3 + GLA_VAL_DIM
    i5 = i4 + GATE_RANK
    q = proj[..., :i1].reshape(B, S, GLA_HEADS, GLA_DK) * (GLA_DK ** -0.5)
    k = proj[..., i1:i2].reshape(B, S, GLA_HEADS, GLA_DK)
    v = proj[..., i2:i3].reshape(B, S, GLA_HEADS, GLA_DV)
    r = proj[..., i3:i4].reshape(B, S, GLA_HEADS, GLA_DV)
    g_f = proj[..., i4:i5]
    g_b = proj[..., i5:]

    def log_gate(g_lr, w_up, bias):
        z = (g_lr @ w_up + bias).astype(jnp.float32)
        return (jax.nn.log_sigmoid(z) / GATE_NORMALIZER).reshape(B, S, GLA_HEADS, GLA_DK)

    la_f = log_gate(g_f, w_gate_up[0], b_gate[0])
    la_b = log_gate(g_b, w_gate_up[1], b_gate[1])
    o_fwd = gla_chunked(q, k, v, la_f, strict=False)
    flip = lambda a: jnp.flip(a, axis=1)
    o_bwd = flip(gla_chunked(flip(q), flip(k), flip(v), flip(la_b), strict=True))
    o = (o_fwd + o_bwd).astype(h.dtype)
    o = rms_norm(o, head_gain) * jax.nn.silu(r)
    return o.reshape(B, S, GLA_VAL_DIM) @ w_out


def swiglu(h, w_gate, w_up, w_down):
    return (jax.nn.silu(h @ w_gate) * (h @ w_up)) @ w_down


def setup_inputs(seed: int = 0) -> dict:
    key = jax.random.key(seed)
    ks = jax.random.split(key, 16)
    nrm = jax.random.normal
    f32 = jnp.float32
    return {
        "x": nrm(ks[0], (BATCH, SEQ, D_MODEL), f32),
        "norm_mix": 1.0 + 0.05 * nrm(ks[1], (DEPTH, D_MODEL), f32),
        "norm_ffn": 1.0 + 0.05 * nrm(ks[2], (DEPTH, D_MODEL), f32),
        "norm_final": 1.0 + 0.05 * nrm(ks[3], (D_MODEL,), f32),
        "w_pool": nrm(ks[4], (N_POOL_LAYERS, N_POOL_GROUPS, POOL_GROUP, POOL_GROUP), f32) * POOL_GROUP ** -0.5,
        "pool_scale": 1.0 + 0.05 * nrm(ks[5], (N_POOL_LAYERS, D_MODEL), f32),
        "w_gla_in": nrm(ks[6], (N_GLA_LAYERS, D_MODEL, GLA_IN), f32) * D_MODEL ** -0.5,
        "w_gate_up": nrm(ks[7], (N_GLA_LAYERS, 2, GATE_RANK, GLA_KEY_DIM), f32) * GATE_RANK ** -0.5,
        "b_gate": 0.1 * nrm(ks[8], (N_GLA_LAYERS, 2, GLA_KEY_DIM), f32),
        "gla_head_norm": 1.0 + 0.05 * nrm(ks[9], (N_GLA_LAYERS, GLA_DV), f32),
        "w_gla_out": nrm(ks[10], (N_GLA_LAYERS, GLA_VAL_DIM, D_MODEL), f32) * GLA_VAL_DIM ** -0.5,
        "w_ffn_gate": nrm(ks[11], (DEPTH, D_MODEL, D_FF), f32) * D_MODEL ** -0.5,
        "w_ffn_up": nrm(ks[12], (DEPTH, D_MODEL, D_FF), f32) * D_MODEL ** -0.5,
        "w_ffn_down": nrm(ks[13], (DEPTH, D_FF, D_MODEL), f32) * D_FF ** -0.5,
    }


def reference(x, norm_mix, norm_ffn, norm_final, w_pool, pool_scale, w_gla_in, w_gate_up, b_gate,
              gla_head_norm, w_gla_out, w_ffn_gate, w_ffn_up, w_ffn_down):
    for i in range(DEPTH):
        j = i // N_MIXERS
        h = rms_norm(x, norm_mix[i])
        if i % N_MIXERS == 0:
            x = x + pool_mixer(h, w_pool[j], pool_scale[j])
        else:
            x = x + gla_mixer(h, w_gla_in[j], w_gate_up[j], b_gate[j], gla_head_norm[j], w_gla_out[j])
        h = rms_norm(x, norm_ffn[i])
        x = x + swiglu(h, w_ffn_gate[i], w_ffn_up[i], w_ffn_down[i])
    return rms_norm(x, norm_final)
```

```cpp
#include <hip/hip_runtime.h>
#include <hip/hip_cooperative_groups.h>
#include <cstdio>
#include <cstdint>
namespace cg = cooperative_groups;

#define LAS __attribute__((address_space(3)))
typedef unsigned short bf16_t;
typedef short bf16x8 __attribute__((ext_vector_type(8)));
typedef short s16x4 __attribute__((ext_vector_type(4)));
typedef float f32x4 __attribute__((ext_vector_type(4)));
typedef float f32x16 __attribute__((ext_vector_type(16)));
typedef float f32x2 __attribute__((ext_vector_type(2)));
typedef __bf16 bf16x2_t __attribute__((ext_vector_type(2)));
typedef unsigned u32x4 __attribute__((ext_vector_type(4)));
typedef unsigned u32x2 __attribute__((ext_vector_type(2)));

constexpr int DM = 1024, BATCH = 32, SEQ = 2048, MTOK = BATCH * SEQ, DFF = 2816, NGU = 2 * DFF, GIN = 3104, GINP = 3328;
constexpr int NWAVES = 8, NTHREADS = 512;
constexpr float EPS = 1e-6f;

constexpr size_t MiB = 1u << 20;
constexpr size_t SZ_WGU = (size_t)NGU * DM * 2, SZ_WD = (size_t)DM * DFF * 2, SZ_WIN = (size_t)GINP * DM * 2, SZ_WOUT = (size_t)DM * DM * 2, SZ_WPOOL = (size_t)DM * 256 * 2;
constexpr size_t WS_WGU = 1 * MiB, WS_WD = WS_WGU + 4 * SZ_WGU, WS_WIN = WS_WD + 4 * SZ_WD, WS_WOUT = WS_WIN + 2 * SZ_WIN, WS_WPOOL = WS_WOUT + 2 * SZ_WOUT, WS_WEND = WS_WPOOL + 2 * SZ_WPOOL;
static_assert(WS_WEND <= 100 * MiB, "weights");
constexpr size_t WS_SSQ = 100 * MiB;
constexpr size_t WS_GBUF = 104 * MiB;
constexpr size_t WS_XB = 112 * MiB;
constexpr size_t WS_R2 = 240 * MiB;
constexpr size_t WS_OB1 = 368 * MiB;
constexpr size_t WS_R1 = 496 * MiB;
constexpr size_t WS_END = 912 * MiB;

constexpr int LDS_BYTES = 147456;

__device__ __forceinline__ unsigned pk2(float lo, float hi) { f32x2 v = {lo, hi}; bf16x2_t b = __builtin_convertvector(v, bf16x2_t); return __builtin_bit_cast(unsigned, b); }
__device__ __forceinline__ float bf2f(unsigned u16) { return __uint_as_float(u16 << 16); }
__device__ __forceinline__ float bflo(unsigned w) { return __uint_as_float(w << 16); }
__device__ __forceinline__ float bfhi(unsigned w) { return __uint_as_float(w & 0xffff0000u); }
__device__ __forceinline__ float wave_sum(float v) {
#pragma unroll
    for (int o = 1; o < 64; o <<= 1) v += __shfl_xor(v, o);
    return v;
}
__device__ __forceinline__ float fexp(float x) { return __builtin_amdgcn_exp2f(x * 1.4426950408889634f); }
__device__ __forceinline__ float flog(float x) { return __builtin_amdgcn_logf(x) * 0.6931471805599453f; }
__device__ __forceinline__ float silu_f(float g) { return g * __builtin_amdgcn_rcpf(1.f + __builtin_amdgcn_exp2f(g * -1.4426950408889634f)); }
__device__ __forceinline__ float row_rstd(const float* ssq, int row) {
    const f32x4 a = *(const f32x4*)(ssq + (size_t)row * 4);
    const float s = (a.x + a.y) + (a.z + a.w);
    return rsqrtf(s * (1.f / 1024.f) + EPS);
}

namespace pg8 {
constexpr int BM = 256, BK = 64, HALF = 128, HTB = HALF * BK * 2, STAGE_BYTES = 8 * HTB, NXCD = 8, WGM = 4;
__host__ __device__ __forceinline__ int lds_byte(int r, int c) { const int st = (r >> 4) * 2 + (c >> 5), rr = r & 15, cc = c & 31, ob = rr * 64 + cc * 2; return st * 1024 + (ob ^ (((ob >> 9) & 1) << 5)); }
__host__ __device__ __forceinline__ void stage_rc(int b, int& R, int& C) { const int st = b / 1024, sb = b % 1024, swz = sb ^ (((sb >> 9) & 1) << 5); R = (st >> 1) * 16 + swz / 64; C = (st & 1) * 32 + (swz % 64) / 2; }
__host__ __device__ __forceinline__ int perm32(int rho) { const int n = rho >> 4, i = rho & 15; return 8 * (i >> 2) + 4 * n + (i & 3); }

struct Unit { int pm, pn; };
struct Gemm { const bf16_t* A; const bf16_t* Bt; int K, lda, ldb, a_pn_off; };

struct StaticOrder {
    int nM, nN, nwg, G, c; bool rev = false;
    __host__ __device__ void init(int M, int N, int G_, int c_) { nM = M / BM; nN = N / BM; nwg = nM * nN; G = G_; c = c_; }
    __host__ __device__ bool next(int i, Unit& u) const {
        const int nr = (nwg + G - 1) / G; if (i >= nr) return false;
        const long L = (long)(rev ? nr - 1 - i : i) * G + c; if (L >= nwg) return false;
        int wgid = (int)L; { const int q = nwg / NXCD, r = nwg % NXCD, xcd = wgid % NXCD, off = wgid / NXCD; wgid = (xcd < r ? xcd * (q + 1) : r * (q + 1) + (xcd - r) * q) + off; }
        const int nig = WGM * nN, gid = wgid / nig, fm = gid * WGM, gsz = (nM - fm) < WGM ? (nM - fm) : WGM;
        u.pm = fm + ((wgid % nig) % gsz); u.pn = (wgid % nig) / gsz; return true;
    }
};


__device__ __forceinline__ const LAS float* rstd_panel(LAS unsigned char* lds, const float* ssq, int pm, int tid) {
    LAS float* RT = (LAS float*)(lds + STAGE_BYTES + 4096); volatile LAS int* TG = (volatile LAS int*)(lds + STAGE_BYTES + 8208);
    const int slot = (pm >> 3) & 3;
    asm volatile("s_waitcnt lgkmcnt(0)" ::: "memory"); __builtin_amdgcn_s_barrier(); asm volatile("" ::: "memory");
    if (TG[slot] != pm) {
        if (tid < 256) RT[slot * 256 + tid] = row_rstd(ssq, pm * BM + tid);
        asm volatile("s_waitcnt lgkmcnt(0)" ::: "memory"); __builtin_amdgcn_s_barrier(); asm volatile("" ::: "memory");
        if (tid == 0) TG[slot] = pm;
    }
    return RT + slot * 256;
}
struct EpiGU {
    static constexpr bool PERM = true;
    bf16_t* H; const float* ssq;
    __device__ __forceinline__ void operator()(const f32x4 (&acc)[2][2][4][2], const Unit& u, int wr, int wc, int fr, int fq, LAS unsigned char* lds, int tid) const {
        const int row0 = u.pm * BM + wr * 64 + fr, col0 = u.pn * 128 + wc * 32 + 8 * fq;
        const LAS float* RT = rstd_panel(lds, ssq, u.pm, tid);
#pragma unroll
        for (int ai = 0; ai < 2; ++ai) {
            float rs[4];
#pragma unroll
            for (int m = 0; m < 4; ++m) rs[m] = RT[wr * 64 + fr + ai * HALF + m * 16];
#pragma unroll
            for (int m = 0; m < 4; ++m) {
                const int row = row0 + ai * HALF + m * 16; const float r = rs[m];
                const f32x4 g0 = acc[ai][0][m][0] * r, g1 = acc[ai][0][m][1] * r, u0 = acc[ai][1][m][0] * r, u1 = acc[ai][1][m][1] * r;
                u32x4 w;
                w.x = pk2(silu_f(g0[0]) * u0[0], silu_f(g0[1]) * u0[1]); w.y = pk2(silu_f(g0[2]) * u0[2], silu_f(g0[3]) * u0[3]);
                w.z = pk2(silu_f(g1[0]) * u1[0], silu_f(g1[1]) * u1[1]); w.w = pk2(silu_f(g1[2]) * u1[2], silu_f(g1[3]) * u1[3]);
                *(u32x4*)(H + (size_t)row * DFF + col0) = w;
            }
        }
    }
};
struct EpiProj {
    static constexpr bool PERM = true;
    bf16_t* P; float* gbuf; const float* ssq;
    __device__ __forceinline__ void operator()(const f32x4 (&acc)[2][2][4][2], const Unit& u, int wr, int wc, int fr, int fq, LAS unsigned char* lds, int tid) const {
        const int row0 = u.pm * BM + wr * 64 + fr, col0 = u.pn * BM + wc * 32 + 8 * fq;
        const bool gate = (u.pn == 12) && (wc == 0);
        const LAS float* RT = rstd_panel(lds, ssq, u.pm, tid);
#pragma unroll
        for (int ai = 0; ai < 2; ++ai) {
            float rs[4];
#pragma unroll
            for (int m = 0; m < 4; ++m) rs[m] = RT[wr * 64 + fr + ai * HALF + m * 16];
#pragma unroll
            for (int m = 0; m < 4; ++m) {
                const int row = row0 + ai * HALF + m * 16; const float r = rs[m];
#pragma unroll
                for (int bj = 0; bj < 2; ++bj) {
                    const f32x4 v0 = acc[ai][bj][m][0] * r, v1 = acc[ai][bj][m][1] * r;
                    u32x4 w; w.x = pk2(v0[0], v0[1]); w.y = pk2(v0[2], v0[3]); w.z = pk2(v1[0], v1[1]); w.w = pk2(v1[2], v1[3]);
                    *(u32x4*)(P + (size_t)row * GINP + col0 + bj * HALF) = w;
                    if (bj == 0 && gate) { float* gp = gbuf + (size_t)row * 32 + 8 * fq; *(f32x4*)gp = v0; *(f32x4*)(gp + 4) = v1; }
                }
            }
        }
    }
};
struct EpiRes {
    static constexpr bool PERM = true;
    const bf16_t* xin; bf16_t* xb; float* ssq;
    __device__ __forceinline__ void operator()(const f32x4 (&acc)[2][2][4][2], const Unit& u, int wr, int wc, int fr, int fq, LAS unsigned char* lds, int tid) const {
        const int col0 = u.pn * BM + wc * 32 + 8 * fq;
        LAS float* RED = (LAS float*)(lds + STAGE_BYTES);
#pragma unroll
        for (int ai = 0; ai < 2; ++ai) {
            u32x4 bw[4][2];
#pragma unroll
            for (int m = 0; m < 4; ++m)
#pragma unroll
                for (int bj = 0; bj < 2; ++bj) bw[m][bj] = *(const u32x4*)(xin + (size_t)(u.pm * BM + ai * HALF + wr * 64 + m * 16 + fr) * DM + col0 + bj * HALF);
#pragma unroll
            for (int m = 0; m < 4; ++m) {
                const int rl = ai * HALF + wr * 64 + m * 16 + fr;
                bf16_t* xp = xb + (size_t)(u.pm * BM + rl) * DM + col0;
                float sq = 0.f;
#pragma unroll
                for (int bj = 0; bj < 2; ++bj) {
                    const u32x4 w0 = bw[m][bj];
                    const f32x4 o0 = (f32x4){bflo(w0.x), bfhi(w0.x), bflo(w0.y), bfhi(w0.y)} + acc[ai][bj][m][0];
                    const f32x4 o1 = (f32x4){bflo(w0.z), bfhi(w0.z), bflo(w0.w), bfhi(w0.w)} + acc[ai][bj][m][1];
                    sq += ((o0[0] * o0[0] + o0[1] * o0[1]) + (o0[2] * o0[2] + o0[3] * o0[3])) + ((o1[0] * o1[0] + o1[1] * o1[1]) + (o1[2] * o1[2] + o1[3] * o1[3]));
                    u32x4 w; w.x = pk2(o0[0], o0[1]); w.y = pk2(o0[2], o0[3]); w.z = pk2(o1[0], o1[1]); w.w = pk2(o1[2], o1[3]);
                    *(u32x4*)(xp + bj * HALF) = w;
                }
                sq += __shfl_xor(sq, 16); sq += __shfl_xor(sq, 32);
                if (fq == 0) RED[wc * 256 + rl] = sq;
            }
        }
        asm volatile("s_waitcnt lgkmcnt(0)" ::: "memory"); __builtin_amdgcn_s_barrier(); asm volatile("" ::: "memory");
        if (tid < 256) ssq[(size_t)(u.pm * BM + tid) * 4 + u.pn] = (RED[tid] + RED[256 + tid]) + (RED[512 + tid] + RED[768 + tid]);
    }
};

template <class Epi, class Sched>
__device__ __forceinline__ void gemm_phase(LAS unsigned char* lds, const Gemm g, const Sched& S, const Epi& E) {
    int tid = threadIdx.x; asm volatile("" : "+v"(tid));
    const int wid = __builtin_amdgcn_readfirstlane(tid >> 6), lane = tid & 63, wr = wid >> 2, wc = wid & 3, fr = lane & 15, fq = lane >> 4;
    const int K = g.K, nt = K / BK;
    unsigned voffA[2], voffB[2];
#pragma unroll
    for (int i = 0; i < 2; ++i) { int R, C; stage_rc(tid * 16 + i * 8192, R, C); const int Rb = Epi::PERM ? ((R & ~31) + perm32(R & 31)) : R;
        voffA[i] = (unsigned)(R * g.lda + C) * 2u; voffB[i] = (unsigned)(Rb * g.ldb + C) * 2u; }
    const size_t kstep = (size_t)(BK * 2);
    const size_t hstepA = (size_t)HALF * g.lda * 2, hstepB = (size_t)HALF * g.ldb * 2;
    const size_t tstepA = 2 * hstepA, tstepB = 2 * hstepB, apn = (size_t)g.a_pn_off * 2;
    const unsigned ldsw = (unsigned)wid * 1024u;
    const int aoff = lds_byte(wr * 64 + fr, fq * 8), boff = lds_byte(wc * 32 + fr, fq * 8);
#define PG8_SA(b, h) (((b) * 2 + (h)) * HTB)
#define PG8_SB(b, h) ((4 + (b) * 2 + (h)) * HTB)
#define PG8_STAGE(bufoff, gbase, voff) do { _Pragma("unroll") for (int _i = 0; _i < 2; ++_i) \
        __builtin_amdgcn_global_load_lds((const unsigned*)((const char*)(gbase) + (voff)[_i]), (LAS unsigned*)(lds + (bufoff) + ldsw + _i * 8192), 16, 0, 0); } while (0)
#define PG8_LDA(dst, b, h) do { _Pragma("unroll") for (int m = 0; m < 4; ++m) _Pragma("unroll") for (int k = 0; k < 2; ++k) dst[m][k] = *(const LAS bf16x8*)(lds + PG8_SA(b, h) + aoff + m * 2048 + k * 1024); } while (0)
#define PG8_LDB(dst, b, h) do { _Pragma("unroll") for (int n = 0; n < 2; ++n) _Pragma("unroll") for (int k = 0; k < 2; ++k) dst[n][k] = *(const LAS bf16x8*)(lds + PG8_SB(b, h) + boff + n * 2048 + k * 1024); } while (0)
#define PG8_MMA(ai, bj, At, Bt) do { __builtin_amdgcn_s_setprio(1); _Pragma("unroll") for (int m = 0; m < 4; ++m) _Pragma("unroll") for (int n = 0; n < 2; ++n) _Pragma("unroll") for (int k = 0; k < 2; ++k) \
        acc[ai][bj][m][n] = __builtin_amdgcn_mfma_f32_16x16x32_bf16(Bt[n][k], At[m][k], acc[ai][bj][m][n], 0, 0, 0); __builtin_amdgcn_s_setprio(0); } while (0)
#define PG8_WAIT_V(n) asm volatile("s_waitcnt vmcnt(" #n ")" ::: "memory")
#define PG8_WAIT_L(n) asm volatile("s_waitcnt lgkmcnt(" #n ")" ::: "memory")
#define PG8_BAR __builtin_amdgcn_s_barrier()
#define PG8_SCHED __builtin_amdgcn_sched_barrier(0)
    Unit cur, nxt; int ui = 0;
    if (!S.next(0, cur)) return;
    f32x4 acc[2][2][4][2];
#pragma unroll
    for (int a = 0; a < 2; ++a)
#pragma unroll
        for (int b = 0; b < 2; ++b)
#pragma unroll
            for (int m = 0; m < 4; ++m)
#pragma unroll
                for (int n = 0; n < 2; ++n) acc[a][b][m][n] = (f32x4){0.f, 0.f, 0.f, 0.f};
    bf16x8 At[4][2], B0[2][2], B1[2][2];
    const char* cA = (const char*)g.A + (size_t)cur.pm * tstepA + (size_t)cur.pn * apn; const char* cB = (const char*)g.Bt + (size_t)cur.pn * tstepB;
    PG8_STAGE(PG8_SB(0, 0), cB, voffB); PG8_STAGE(PG8_SB(0, 1), cB + hstepB, voffB); PG8_STAGE(PG8_SA(0, 0), cA, voffA); PG8_STAGE(PG8_SA(0, 1), cA + hstepA, voffA);
    if (wr == 1) PG8_BAR;
    PG8_WAIT_V(2); PG8_BAR;
    PG8_STAGE(PG8_SB(1, 0), cB + kstep, voffB); PG8_STAGE(PG8_SA(1, 0), cA + kstep, voffA); PG8_STAGE(PG8_SB(1, 1), cB + hstepB + kstep, voffB);
    PG8_WAIT_V(6); PG8_BAR;
    for (;;) {
        const bool has_next = S.next(ui + 1, nxt);
        const char* nA = has_next ? (const char*)g.A + (size_t)nxt.pm * tstepA + (size_t)nxt.pn * apn : cA; const char* nB = has_next ? (const char*)g.Bt + (size_t)nxt.pn * tstepB : cB;
        for (int t = 0; t < nt; t += 2) {
            const bool last = (t == nt - 2);
            const char* a1 = cA + (size_t)(t + 1) * kstep;
            const char* a2 = last ? nA : cA + (size_t)(t + 2) * kstep; const char* b2 = last ? nB : cB + (size_t)(t + 2) * kstep;
            const char* a3 = a2 + kstep; const char* b3 = b2 + kstep;
            PG8_LDB(B0, 0, 0); PG8_LDB(B1, 0, 1); PG8_SCHED; PG8_LDA(At, 0, 0); PG8_STAGE(PG8_SA(1, 1), a1 + hstepA, voffA);
            PG8_WAIT_V(8); PG8_WAIT_L(0); PG8_BAR; PG8_MMA(0, 0, At, B0); PG8_MMA(0, 1, At, B1); PG8_BAR; PG8_SCHED;
            PG8_LDA(At, 0, 1); PG8_STAGE(PG8_SB(0, 0), b2, voffB); PG8_STAGE(PG8_SB(0, 1), b2 + hstepB, voffB); PG8_STAGE(PG8_SA(0, 0), a2, voffA);
            PG8_WAIT_V(8); PG8_WAIT_L(0); PG8_BAR; PG8_MMA(1, 0, At, B0); PG8_MMA(1, 1, At, B1); PG8_BAR; PG8_SCHED;
            PG8_LDB(B0, 1, 0); PG8_LDB(B1, 1, 1); PG8_SCHED; PG8_LDA(At, 1, 0); PG8_STAGE(PG8_SA(0, 1), a2 + hstepA, voffA);
            PG8_WAIT_V(8); PG8_WAIT_L(0); PG8_BAR; PG8_MMA(0, 0, At, B0); PG8_MMA(0, 1, At, B1); PG8_BAR; PG8_SCHED;
            PG8_LDA(At, 1, 1); PG8_STAGE(PG8_SB(1, 0), b3, voffB); PG8_STAGE(PG8_SB(1, 1), b3 + hstepB, voffB); PG8_STAGE(PG8_SA(1, 0), a3, voffA);
            PG8_WAIT_V(8); PG8_WAIT_L(0); PG8_BAR; PG8_MMA(1, 0, At, B0); PG8_MMA(1, 1, At, B1); PG8_BAR; PG8_SCHED;
        }
        if (wr == 0) PG8_BAR;
        E(acc, cur, wr, wc, fr, fq, lds, tid);
        if (!has_next) break;
#pragma unroll
        for (int a = 0; a < 2; ++a)
#pragma unroll
            for (int b = 0; b < 2; ++b)
#pragma unroll
                for (int m = 0; m < 4; ++m)
#pragma unroll
                    for (int n = 0; n < 2; ++n) acc[a][b][m][n] = (f32x4){0.f, 0.f, 0.f, 0.f};
        cur = nxt; cA = nA; cB = nB; ++ui;
        if (wr == 1) PG8_BAR;
    }
    PG8_WAIT_V(0);
    PG8_BAR;
#undef PG8_SA
#undef PG8_SB
#undef PG8_STAGE
#undef PG8_LDA
#undef PG8_LDB
#undef PG8_MMA
#undef PG8_WAIT_V
#undef PG8_WAIT_L
#undef PG8_BAR
#undef PG8_SCHED
}
}

struct Params {
    const float* x; const float* norm_mix; const float* norm_ffn; const float* norm_final;
    const float* w_pool; const float* pool_scale; const float* w_gla_in; const float* w_gate_up; const float* b_gate;
    const float* gla_head_norm; const float* w_gla_out; const float* w_ffn_gate; const float* w_ffn_up; const float* w_ffn_down;
    float* out; unsigned char* ws;
};

struct P0Item { const float* W; bf16_t* WT; const float* kscale; const float* nscale; int N, ldt, k0, n0, drow0; float cscale; };
__device__ __forceinline__ P0Item p0_decode(const Params& p, int it) {
    constexpr int I_G = (DM / 64) * (DFF / 32), I_D = (DFF / 64) * (DM / 32), I_L = 2 * I_G + I_D;
    constexpr int I_IN = (DM / 64) * (GIN / 32), I_OUT = (DM / 64) * (DM / 32), I_J = I_IN + I_OUT;
    constexpr int I_P = (256 / 64) * (256 / 32);
    unsigned char* ws = p.ws; P0Item q; int r = it;
    if (r < 4 * I_L) {
        const int l = r / I_L; r -= l * I_L;
        if (r < 2 * I_G) {
            const int up = r / I_G; r -= up * I_G;
            const int nb = r % (DFF / 32), kb = r / (DFF / 32), n0 = nb * 32;
            q.W = (up ? p.w_ffn_up : p.w_ffn_gate) + (size_t)l * DM * DFF; q.N = DFF; q.WT = (bf16_t*)(ws + WS_WGU + l * SZ_WGU); q.ldt = DM; q.k0 = kb * 64; q.n0 = n0;
            q.drow0 = (n0 >> 7) * 256 + up * 128 + (n0 & 127); q.kscale = p.norm_ffn + l * DM; q.nscale = nullptr; q.cscale = 1.f;
        } else {
            r -= 2 * I_G;
            const int nb = r % (DM / 32), kb = r / (DM / 32), n0 = nb * 32;
            q.W = p.w_ffn_down + (size_t)l * DFF * DM; q.N = DM; q.WT = (bf16_t*)(ws + WS_WD + l * SZ_WD); q.ldt = DFF; q.k0 = kb * 64; q.n0 = n0; q.drow0 = n0; q.kscale = nullptr; q.nscale = nullptr; q.cscale = 1.f;
        }
        return q;
    }
    r -= 4 * I_L;
    if (r < 2 * I_J) {
        const int j = r / I_J; r -= j * I_J;
        if (r < I_IN) {
            const int nb = r % (GIN / 32), kb = r / (GIN / 32), n0 = nb * 32;
            q.W = p.w_gla_in + (size_t)j * DM * GIN; q.N = GIN; q.WT = (bf16_t*)(ws + WS_WIN + j * SZ_WIN); q.ldt = DM; q.k0 = kb * 64; q.n0 = n0; q.drow0 = n0;
            q.kscale = p.norm_mix + (2 * j + 1) * DM; q.nscale = nullptr; q.cscale = n0 < 512 ? 0.08838834764831845f : 1.f;
        } else {
            r -= I_IN;
            const int nb = r % (DM / 32), kb = r / (DM / 32), n0 = nb * 32;
            q.W = p.w_gla_out + (size_t)j * DM * DM; q.N = DM; q.WT = (bf16_t*)(ws + WS_WOUT + j * SZ_WOUT); q.ldt = DM; q.k0 = kb * 64; q.n0 = n0; q.drow0 = n0; q.kscale = nullptr; q.nscale = nullptr; q.cscale = 1.f;
        }
        return q;
    }
    r -= 2 * I_J;
    {
        const int jg = r / I_P; r -= jg * I_P; const int j = jg >> 2, g = jg & 3;
        const int nb = r % 8, kb = r / 8, n0 = nb * 32;
        q.W = p.w_pool + (size_t)jg * 256 * 256; q.N = 256; q.WT = (bf16_t*)(ws + WS_WPOOL + j * SZ_WPOOL); q.ldt = 256; q.k0 = kb * 64; q.n0 = n0; q.drow0 = g * 256 + n0;
        q.kscale = nullptr; q.nscale = p.pool_scale + j * DM + g * 256; q.cscale = 1.f;
    }
    return q;
}
struct P0Regs { float v[32]; f32x4 ka, kb; float ns[4]; };
__device__ __forceinline__ void p0_load(const P0Item& q, int lane, P0Regs& r) {
#pragma unroll
    for (int i = 0; i < 32; ++i) { const int kk = 2 * i + (lane >> 5); r.v[i] = q.W[(size_t)(q.k0 + kk) * q.N + q.n0 + (lane & 31)]; }
    const int c = lane & 7;
    r.ka = (f32x4){1.f, 1.f, 1.f, 1.f}; r.kb = r.ka;
    if (q.kscale) { r.ka = *(const f32x4*)(q.kscale + q.k0 + 8 * c); r.kb = *(const f32x4*)(q.kscale + q.k0 + 8 * c + 4); }
#pragma unroll
    for (int j = 0; j < 4; ++j) r.ns[j] = (q.nscale ? q.nscale[q.n0 + (lane >> 3) + 8 * j] : 1.f) * q.cscale;
}
__device__ __forceinline__ void p0_finish(const P0Item& q, LAS float* scr, int lane, const P0Regs& r) {
#pragma unroll
    for (int i = 0; i < 32; ++i) { const int kk = 2 * i + (lane >> 5); scr[kk * 33 + (lane & 31)] = r.v[i]; }
    asm volatile("s_waitcnt lgkmcnt(0)" ::: "memory");
    const int c = lane & 7;
#pragma unroll
    for (int j = 0; j < 4; ++j) { const int n = (lane >> 3) + 8 * j; const LAS float* s = scr + (8 * c) * 33 + n;
        const float ns = r.ns[j];
        u32x4 o; o.x = pk2(s[0 * 33] * r.ka[0] * ns, s[1 * 33] * r.ka[1] * ns); o.y = pk2(s[2 * 33] * r.ka[2] * ns, s[3 * 33] * r.ka[3] * ns);
        o.z = pk2(s[4 * 33] * r.kb[0] * ns, s[5 * 33] * r.kb[1] * ns); o.w = pk2(s[6 * 33] * r.kb[2] * ns, s[7 * 33] * r.kb[3] * ns);
        *(u32x4*)(q.WT + (size_t)(q.drow0 + n) * q.ldt + q.k0 + 8 * c) = o; }
    asm volatile("s_waitcnt lgkmcnt(0)" ::: "memory");
}

__device__ __forceinline__ void p0_phase(const Params& p, LAS unsigned char* lds) {
    int tid = threadIdx.x; asm volatile("" : "+v"(tid));
    const int lane = tid & 63, wave = __builtin_amdgcn_readfirstlane(tid >> 6);
    LAS float* scr = (LAS float*)(lds + wave * 16384);
    const int gw = blockIdx.x * NWAVES + wave, NGW = gridDim.x * NWAVES;
    constexpr int NITEMS = 4 * (2 * (DM / 64) * (DFF / 32) + (DFF / 64) * (DM / 32)) + 2 * ((DM / 64) * (GIN / 32) + (DM / 64) * (DM / 32)) + 8 * (256 / 64) * (256 / 32);
    unsigned char* ws = p.ws;
    if (gw < NITEMS) {
        P0Item cur = p0_decode(p, gw), nx1 = cur; P0Regs A, B, C;
        p0_load(cur, lane, A);
        if (gw + NGW < NITEMS) { nx1 = p0_decode(p, gw + NGW); p0_load(nx1, lane, B); }
        for (int it = gw; it < NITEMS; it += NGW) {
            P0Item nx2 = nx1;
            if (it + 2 * NGW < NITEMS) { nx2 = p0_decode(p, it + 2 * NGW); p0_load(nx2, lane, C); }
            p0_finish(cur, scr, lane, A);
            cur = nx1; A = B; nx1 = nx2; B = C;
        }
    }
    for (int e = gw * 64 + lane; e < 2 * (GINP - GIN) * DM / 8; e += NGW * 64) {
        const int j = e / ((GINP - GIN) * DM / 8), q = e % ((GINP - GIN) * DM / 8);
        *(u32x4*)(ws + WS_WIN + j * SZ_WIN + (size_t)GIN * DM * 2 + (size_t)q * 16) = (u32x4){0u, 0u, 0u, 0u};
    }
    float* ssq = (float*)(ws + WS_SSQ);
    {
        f32x4 v[4];
#define P0_LOAD(row_) do { const f32x4* xr_ = (const f32x4*)(p.x + (size_t)(row_) * DM) + lane; _Pragma("unroll") for (int j = 0; j < 4; ++j) v[j] = xr_[64 * j]; } while (0)
        if (gw < MTOK) P0_LOAD(gw);
        for (int row = gw; row < MTOK; row += NGW) {
            f32x4 c[4];
#pragma unroll
            for (int j = 0; j < 4; ++j) c[j] = v[j];
            if (row + NGW < MTOK) P0_LOAD(row + NGW);
            float s = 0.f;
            u32x2* xo = (u32x2*)(ws + WS_XB + (size_t)row * DM * 2) + lane;
#pragma unroll
            for (int j = 0; j < 4; ++j) { s += (c[j].x * c[j].x + c[j].y * c[j].y) + (c[j].z * c[j].z + c[j].w * c[j].w); u32x2 w; w.x = pk2(c[j].x, c[j].y); w.y = pk2(c[j].z, c[j].w); xo[64 * j] = w; }
            s = wave_sum(s);
            if (lane < 4) ssq[(size_t)row * 4 + lane] = lane == 0 ? s : 0.f;
        }
#undef P0_LOAD
    }
}

__device__ __forceinline__ void pool_prep_phase(LAS unsigned char* lds, const bf16_t* x, const float* ssq, const float* gain, bf16_t* mixed) {
    int tid = threadIdx.x; asm volatile("" : "+v"(tid));
    LAS float* HT = (LAS float*)lds; LAS float* RS = (LAS float*)(lds + 81920);
    const int nitems = MTOK / 64;
    const int nit = (int)blockIdx.x < nitems ? (nitems - (int)blockIdx.x + (int)gridDim.x - 1) / (int)gridDim.x : 0;
    const int nsteps = nit * 4;
    u32x2 raw[10];
#define PP_GEO(st_) const int g_ = (st_) & 3, tok0_ = ((int)blockIdx.x + ((st_) >> 2) * (int)gridDim.x) * 64, s0_ = tok0_ & (SEQ - 1); \
        const int win_ = 2 << g_, left_ = win_ >> 1, right_ = win_ - 1 - left_, rlo_ = 8 - left_, nrows_ = 64 + left_ + right_;
#define PP_LOAD(st_) do { PP_GEO(st_) _Pragma("unroll") for (int k = 0; k < 10; ++k) { const int e = tid + k * NTHREADS; raw[k] = (u32x2){0u, 0u}; \
        if (e < nrows_ * 64) { const int rr = rlo_ + (e >> 6), c4 = e & 63, pos = s0_ - 8 + rr; \
            if (pos >= 0 && pos < SEQ) raw[k] = *(const u32x2*)(x + (size_t)(tok0_ - 8 + rr) * DM + g_ * 256 + c4 * 4); } } } while (0)
    if (nsteps > 0) PP_LOAD(0);
    for (int st = 0; st < nsteps; ++st) {
        PP_GEO(st)
        if (g_ == 0) {
            if (tid < 79) { const int pos = s0_ - 8 + tid; float r = 0.f; if (pos >= 0 && pos < SEQ) r = row_rstd(ssq, tok0_ - 8 + tid); RS[tid] = r; }
            __syncthreads();
        }
#pragma unroll
        for (int k = 0; k < 10; ++k) {
            const int e = tid + k * NTHREADS;
            if (e < nrows_ * 64) { const int rr = rlo_ + (e >> 6), c4 = e & 63; const u32x2 w = raw[k];
                *(LAS f32x4*)(HT + rr * 256 + c4 * 4) = (f32x4){bflo(w.x), bfhi(w.x), bflo(w.y), bfhi(w.y)} * RS[rr]; }
        }
        __syncthreads();
        if (st + 1 < nsteps) PP_LOAD(st + 1);
        {
            const int cq = tid & 63, tq = tid >> 6;
            const f32x4 gn = *(const f32x4*)(gain + g_ * 256 + cq * 4);
            const int tl0 = tq * 8;
            f32x4 sum = (f32x4){0.f, 0.f, 0.f, 0.f};
            for (int q = -left_; q <= right_; ++q) sum += *(const LAS f32x4*)(HT + (tl0 + 8 + q) * 256 + cq * 4);
#pragma unroll
            for (int tt = 0; tt < 8; ++tt) {
                const int tl = tl0 + tt, pos = s0_ + tl;
                const int lo = (pos - left_) > 0 ? (pos - left_) : 0, hi = (pos + right_ + 1) < SEQ ? (pos + right_ + 1) : SEQ;
                const f32x4 self = *(const LAS f32x4*)(HT + (tl + 8) * 256 + cq * 4);
                const f32x4 o = (sum * __builtin_amdgcn_rcpf((float)(hi - lo)) - self) * gn;
                u32x2 w; w.x = pk2(o[0], o[1]); w.y = pk2(o[2], o[3]);
                *(u32x2*)(mixed + (size_t)(tok0_ + tl) * DM + g_ * 256 + cq * 4) = w;
                if (tt < 7) { sum += *(const LAS f32x4*)(HT + (tl + 8 + right_ + 1) * 256 + cq * 4); sum -= *(const LAS f32x4*)(HT + (tl + 8 - left_) * 256 + cq * 4); }
            }
        }
        __syncthreads();
    }
#undef PP_LOAD
#undef PP_GEO
}

constexpr int GL_QD = 0, GL_KI = 17408, GL_KDT = 34816, GL_VT = 53248, GL_SC = 90112, GL_Z = 99328  , GL_SEG = 132096, GL_EBL = 134144;
#define MFMA32(a, b, c) __builtin_amdgcn_mfma_f32_32x32x16_bf16((a), (b), (c), 0, 0, 0)
#define MFMA16(a, b, c) __builtin_amdgcn_mfma_f32_16x16x32_bf16((a), (b), (c), 0, 0, 0)
__device__ __forceinline__ void gla_scan_phase(LAS unsigned char* lds, const bf16_t* proj, const float* gbuf, const float* wgu  , const float* bg  ,
                                               bf16_t* ob0, bf16_t* ob1) {
    int tid = threadIdx.x; asm volatile("" : "+v"(tid));
    const int lane = tid & 63, wave = __builtin_amdgcn_readfirstlane(tid >> 6);
    const int d = tid & 127, seg = tid >> 7;
    const int r = lane & 31, hh = lane >> 5, fr = lane & 15, fq = lane >> 4;
    for (int item = blockIdx.x; item < BATCH * 8; item += gridDim.x) {
        const int b = item >> 3, h = (item >> 1) & 3, dir = item & 1;
        bf16_t* ob = dir ? ob1 : ob0;
        const int zt = wave >> 2, zd = wave & 3;
        bf16x8 wbh, wbl;
        {
            unsigned hi_[4], lo_[4];
#pragma unroll
            for (int q = 0; q < 4; ++q) {
                const float w0 = wgu[(size_t)(dir * 16 + 8 * hh + 2 * q) * 512 + h * 128 + 32 * zd + r], w1 = wgu[(size_t)(dir * 16 + 8 * hh + 2 * q + 1) * 512 + h * 128 + 32 * zd + r];
                hi_[q] = pk2(w0, w1); lo_[q] = pk2(w0 - bflo(hi_[q]), w1 - bfhi(hi_[q]));
            }
            wbh = __builtin_bit_cast(bf16x8, (u32x4){hi_[0], hi_[1], hi_[2], hi_[3]}); wbl = __builtin_bit_cast(bf16x8, (u32x4){lo_[0], lo_[1], lo_[2], lo_[3]});
        }
        const float zbias = bg[dir * 512 + h * 128 + 32 * zd + r];
        f32x16 S[4];
#pragma unroll
        for (int kt = 0; kt < 4; ++kt)
#pragma unroll
            for (int i = 0; i < 16; ++i) S[kt][i] = 0.f;
        f32x4 gna, gnb;
        { const float* grow = gbuf + (size_t)(b * SEQ + (dir ? SEQ / 64 - 1 : 0) * 64 + 32 * zt + r) * 32 + dir * 16 + 8 * hh; gna = *(const f32x4*)grow; gnb = *(const f32x4*)(grow + 4); }
        for (int n = 0; n < SEQ / 64; ++n) {
            const int c = dir ? (SEQ / 64 - 1 - n) : n;
            const int tok0 = b * SEQ + c * 64;
            const f32x4 ga = gna, gb = gnb;
            const bf16_t* prow = proj + (size_t)(tok0 + 16 * seg) * GINP + h * 128 + d;
            unsigned short qv[16], kv[16];
#pragma unroll
            for (int ii = 0; ii < 16; ++ii) { qv[ii] = prow[(size_t)ii * GINP]; kv[ii] = prow[(size_t)ii * GINP + 512]; }
            const bf16_t* vrow = proj + (size_t)(tok0 + 16 * seg) * GINP + 1024 + h * 256 + 2 * d;
            unsigned vw[16];
#pragma unroll
            for (int ii = 0; ii < 16; ++ii) vw[ii] = *(const unsigned*)(vrow + (size_t)ii * GINP);
            {
                u32x4 ah, al;
                ah.x = pk2(ga[0], ga[1]); ah.y = pk2(ga[2], ga[3]); ah.z = pk2(gb[0], gb[1]); ah.w = pk2(gb[2], gb[3]);
                al.x = pk2(ga[0] - bflo(ah.x), ga[1] - bfhi(ah.x)); al.y = pk2(ga[2] - bflo(ah.y), ga[3] - bfhi(ah.y));
                al.z = pk2(gb[0] - bflo(ah.z), gb[1] - bfhi(ah.z)); al.w = pk2(gb[2] - bflo(ah.w), gb[3] - bfhi(ah.w));
                const bf16x8 gah = __builtin_bit_cast(bf16x8, ah), gal = __builtin_bit_cast(bf16x8, al);
                f32x16 zacc;
#pragma unroll
                for (int i = 0; i < 16; ++i) zacc[i] = zbias;
                zacc = MFMA32(gah, wbh, zacc); zacc = MFMA32(gal, wbh, zacc); zacc = MFMA32(gah, wbl, zacc);
#pragma unroll
                for (int i = 0; i < 16; ++i) *(LAS float*)(lds + GL_Z + ((32 * zt + (i & 3) + 8 * (i >> 2) + 4 * hh) * 128 + 32 * zd + r) * 4) = zacc[i];
            }
            __syncthreads();
            float cs[16];
#pragma unroll
            for (int ii = 0; ii < 16; ++ii) {
                const float z = *(const LAS float*)(lds + GL_Z + ((16 * seg + ii) * 128 + d) * 4);
                cs[ii] = fminf(z, 0.f) * (1.4426950408889634f / 16.f) - __builtin_amdgcn_logf(1.f + __builtin_amdgcn_exp2f(fabsf(z) * -1.4426950408889634f)) * (1.f / 16.f);
            }
            if (dir == 0) {
#pragma unroll
                for (int ii = 1; ii < 16; ++ii) cs[ii] += cs[ii - 1];
                *(LAS float*)(lds + GL_SEG + (seg * 128 + d) * 4) = cs[15];
            } else {
#pragma unroll
                for (int ii = 14; ii >= 0; --ii) cs[ii] += cs[ii + 1];
                *(LAS float*)(lds + GL_SEG + (seg * 128 + d) * 4) = cs[0];
            }
            __syncthreads();
            const float t0 = *(const LAS float*)(lds + GL_SEG + (0 * 128 + d) * 4), t1 = *(const LAS float*)(lds + GL_SEG + (1 * 128 + d) * 4),
                        t2 = *(const LAS float*)(lds + GL_SEG + (2 * 128 + d) * 4), t3 = *(const LAS float*)(lds + GL_SEG + (3 * 128 + d) * 4);
            const float prefix = dir == 0 ? ((seg > 0 ? t0 : 0.f) + (seg > 1 ? t1 : 0.f) + (seg > 2 ? t2 : 0.f))
                                          : ((seg < 1 ? t1 : 0.f) + (seg < 2 ? t2 : 0.f) + (seg < 3 ? t3 : 0.f));
            const float ebl = __builtin_amdgcn_exp2f((t0 + t1) + (t2 + t3));
            unsigned kd[8];
#pragma unroll
            for (int ii = 0; ii < 16; ii += 2) {
                const float e0 = __builtin_amdgcn_exp2f(prefix + cs[ii]), e1 = __builtin_amdgcn_exp2f(prefix + cs[ii + 1]);
                const float q0 = bf2f(qv[ii]), q1 = bf2f(qv[ii + 1]);
                const float k0 = bf2f(kv[ii]) * __builtin_amdgcn_rcpf(e0), k1 = bf2f(kv[ii + 1]) * __builtin_amdgcn_rcpf(e1);
                const unsigned qd = pk2(q0 * e0, q1 * e1);
                const unsigned ki = pk2(k0, k1);
                kd[ii >> 1] = pk2(k0 * ebl, k1 * ebl);
                const int i0 = 16 * seg + ii;
                *(LAS unsigned short*)(lds + GL_QD + i0 * 272 + d * 2) = (unsigned short)(qd & 0xffffu);
                *(LAS unsigned short*)(lds + GL_QD + (i0 + 1) * 272 + d * 2) = (unsigned short)(qd >> 16);
                *(LAS unsigned short*)(lds + GL_KI + i0 * 272 + d * 2) = (unsigned short)(ki & 0xffffu);
                *(LAS unsigned short*)(lds + GL_KI + (i0 + 1) * 272 + d * 2) = (unsigned short)(ki >> 16);
            }
            *(LAS u32x4*)(lds + GL_KDT + d * 144 + seg * 32) = (u32x4){kd[0], kd[1], kd[2], kd[3]};
            *(LAS u32x4*)(lds + GL_KDT + d * 144 + seg * 32 + 16) = (u32x4){kd[4], kd[5], kd[6], kd[7]};
            if (seg == 0) *(LAS float*)(lds + GL_EBL + d * 4) = ebl;
            {
                unsigned c0[8], c1[8];
#pragma unroll
                for (int t = 0; t < 8; ++t) { const unsigned a_ = vw[2 * t], b_ = vw[2 * t + 1]; c0[t] = (a_ & 0xffffu) | (b_ << 16); c1[t] = (a_ >> 16) | (b_ & 0xffff0000u); }
                *(LAS u32x4*)(lds + GL_VT + (2 * d) * 144 + seg * 32) = (u32x4){c0[0], c0[1], c0[2], c0[3]};
                *(LAS u32x4*)(lds + GL_VT + (2 * d) * 144 + seg * 32 + 16) = (u32x4){c0[4], c0[5], c0[6], c0[7]};
                *(LAS u32x4*)(lds + GL_VT + (2 * d + 1) * 144 + seg * 32) = (u32x4){c1[0], c1[1], c1[2], c1[3]};
                *(LAS u32x4*)(lds + GL_VT + (2 * d + 1) * 144 + seg * 32 + 16) = (u32x4){c1[4], c1[5], c1[6], c1[7]};
            }
            __syncthreads();
            {
                const int ti = wave >> 1;
#pragma unroll
                for (int tjj = 0; tjj < 2; ++tjj) {
                    const int tj = 2 * (wave & 1) + tjj;
                    f32x4 a4 = (f32x4){0.f, 0.f, 0.f, 0.f};
#pragma unroll
                    for (int ks = 0; ks < 4; ++ks) {
                        const bf16x8 ka = *(const LAS bf16x8*)(lds + GL_KI + (16 * tj + fr) * 272 + ks * 64 + fq * 16);
                        const bf16x8 qb = *(const LAS bf16x8*)(lds + GL_QD + (16 * ti + fr) * 272 + ks * 64 + fq * 16);
                        a4 = MFMA16(ka, qb, a4);
                    }
                    const int qi = 16 * ti + fr, kj = 16 * tj + 4 * fq;
                    float m[4];
#pragma unroll
                    for (int e = 0; e < 4; ++e) { const bool keep = dir ? (kj + e > qi) : (kj + e <= qi); m[e] = keep ? a4[e] : 0.f; }
                    u32x2 w; w.x = pk2(m[0], m[1]); w.y = pk2(m[2], m[3]);
                    *(LAS u32x2*)(lds + GL_SC + qi * 144 + kj * 2) = w;
                }
            }
            __syncthreads();
            { const int n1 = n + 1 < SEQ / 64 ? n + 1 : n; const float* grow = gbuf + (size_t)(b * SEQ + (dir ? SEQ / 64 - 1 - n1 : n1) * 64 + 32 * zt + r) * 32 + dir * 16 + 8 * hh;
              gna = *(const f32x4*)grow; gnb = *(const f32x4*)(grow + 4); }
            bf16x8 bv[4];
#pragma unroll
            for (int ks = 0; ks < 4; ++ks) bv[ks] = *(const LAS bf16x8*)(lds + GL_VT + (32 * wave + r) * 144 + ks * 32 + hh * 16);
            f32x16 oacc[2];
#pragma unroll
            for (int mt = 0; mt < 2; ++mt) {
#pragma unroll
                for (int i = 0; i < 16; ++i) oacc[mt][i] = 0.f;
#pragma unroll
                for (int ks = 0; ks < 4; ++ks) {
                    const bf16x8 a = *(const LAS bf16x8*)(lds + GL_SC + (32 * mt + r) * 144 + ks * 32 + hh * 16);
                    oacc[mt] = MFMA32(a, bv[ks], oacc[mt]);
                }
            }
#pragma unroll
            for (int kt = 0; kt < 4; ++kt)
#pragma unroll
                for (int s = 0; s < 2; ++s) {
                    u32x4 sp;
                    sp.x = pk2(S[kt][8 * s + 0], S[kt][8 * s + 1]); sp.y = pk2(S[kt][8 * s + 2], S[kt][8 * s + 3]);
                    sp.z = pk2(S[kt][8 * s + 4], S[kt][8 * s + 5]); sp.w = pk2(S[kt][8 * s + 6], S[kt][8 * s + 7]);
                    const bf16x8 sb = __builtin_bit_cast(bf16x8, sp);
#pragma unroll
                    for (int mt = 0; mt < 2; ++mt) {
                        const s16x4 lo = *(const LAS s16x4*)(lds + GL_QD + (32 * mt + r) * 272 + kt * 64 + s * 32 + hh * 8);
                        const s16x4 hi = *(const LAS s16x4*)(lds + GL_QD + (32 * mt + r) * 272 + kt * 64 + s * 32 + hh * 8 + 16);
                        const bf16x8 a = __builtin_shufflevector(lo, hi, 0, 1, 2, 3, 4, 5, 6, 7);
                        oacc[mt] = MFMA32(a, sb, oacc[mt]);
                    }
                }
            {
                bf16_t* obase = ob + (size_t)(tok0 + 4 * hh) * DM + h * 256 + 32 * wave + r;
#pragma unroll
                for (int mt = 0; mt < 2; ++mt)
#pragma unroll
                    for (int i = 0; i < 16; ++i) {
                        const int row = 32 * mt + (i & 3) + 8 * (i >> 2);
                        obase[(size_t)row * DM] = (bf16_t)(pk2(oacc[mt][i], 0.f) & 0xffffu);
                    }
            }
#pragma unroll
            for (int kt = 0; kt < 4; ++kt) {
#pragma unroll
                for (int g4 = 0; g4 < 4; ++g4) {
                    const f32x4 e4 = *(const LAS f32x4*)(lds + GL_EBL + (32 * kt + 8 * g4 + 4 * hh) * 4);
#pragma unroll
                    for (int e = 0; e < 4; ++e) S[kt][4 * g4 + e] *= e4[e];
                }
#pragma unroll
                for (int ks = 0; ks < 4; ++ks) {
                    const bf16x8 a = *(const LAS bf16x8*)(lds + GL_KDT + (32 * kt + r) * 144 + ks * 32 + hh * 16);
                    S[kt] = MFMA32(a, bv[ks], S[kt]);
                }
            }
        }
        __syncthreads();
    }
}

constexpr int G2_SET = 43008, G2_QD = 0, G2_KDT = 8704, G2_VT = 18944, G2_SC = 39424, G2_EBL = 41984;
constexpr int G2_KI = 2 * G2_SET, G2_Z = G2_KI + 8704, G2_SEG = G2_Z + 16384;
#define G2_BAR() do { asm volatile("s_waitcnt lgkmcnt(0)" ::: "memory"); __builtin_amdgcn_s_barrier(); asm volatile("" ::: "memory"); } while (0)
__device__ __forceinline__ void gla_scan_phase2(LAS unsigned char* lds, const bf16_t* proj, const float* gbuf, const float* wgu  , const float* bg  ,
                                                bf16_t* ob0, bf16_t* ob1) {
    int tid = threadIdx.x; asm volatile("" : "+v"(tid));
    const int lane = tid & 63, wave = __builtin_amdgcn_readfirstlane(tid >> 6);
    const int r = lane & 31, hh = lane >> 5, fr = lane & 15, fq = lane >> 4;
    constexpr int CH = 32, NCH = SEQ / CH;
    for (int item = blockIdx.x; item < BATCH * 8; item += gridDim.x) {
        const int b = item >> 3, h = (item >> 1) & 3, dir = item & 1;
        if (wave < 4) {
            const int d = tid & 127, seg = (tid >> 7) & 1;
            const int zd = wave;
            bf16x8 wbh, wbl;
            {
                unsigned hi_[4], lo_[4];
#pragma unroll
                for (int q = 0; q < 4; ++q) {
                    const float w0 = wgu[(size_t)(dir * 16 + 8 * hh + 2 * q) * 512 + h * 128 + 32 * zd + r], w1 = wgu[(size_t)(dir * 16 + 8 * hh + 2 * q + 1) * 512 + h * 128 + 32 * zd + r];
                    hi_[q] = pk2(w0, w1); lo_[q] = pk2(w0 - bflo(hi_[q]), w1 - bfhi(hi_[q]));
                }
                wbh = __builtin_bit_cast(bf16x8, (u32x4){hi_[0], hi_[1], hi_[2], hi_[3]}); wbl = __builtin_bit_cast(bf16x8, (u32x4){lo_[0], lo_[1], lo_[2], lo_[3]});
            }
            const float zbias = bg[dir * 512 + h * 128 + 32 * zd + r];
            const __amdgpu_buffer_rsrc_t prs = __builtin_amdgcn_make_buffer_rsrc((void*)proj, 0, (unsigned)((size_t)MTOK * GINP * 2), 0x00020000);
            const unsigned qvoff = (unsigned)((16 * seg * GINP + h * 128 + d) * 2), vvoff = (unsigned)((16 * seg * GINP + 1024 + h * 256 + 2 * d) * 2);
            f32x4 gna, gnb;
            { const float* grow = gbuf + (size_t)(b * SEQ + (dir ? NCH - 1 : 0) * CH + r) * 32 + dir * 16 + 8 * hh; gna = *(const f32x4*)grow; gnb = *(const f32x4*)(grow + 4); }
            for (int n = 0; n <= NCH; ++n) {
                if (n < NCH) {
                    const int tok0 = b * SEQ + (dir ? NCH - 1 - n : n) * CH;
                    LAS unsigned char* set = lds + (n & 1) * G2_SET;
                    const f32x4 ga = gna, gb = gnb;
                    const unsigned srow = (unsigned)tok0 * (unsigned)(GINP * 2);
                    unsigned short qv[16], kv[16];
#pragma unroll
                    for (int ii = 0; ii < 16; ++ii) { qv[ii] = __builtin_amdgcn_raw_buffer_load_b16(prs, qvoff, srow + (unsigned)(ii * GINP * 2), 0);
                                                       kv[ii] = __builtin_amdgcn_raw_buffer_load_b16(prs, qvoff + 1024u, srow + (unsigned)(ii * GINP * 2), 0); }
                    unsigned vw[16];
#pragma unroll
                    for (int ii = 0; ii < 16; ++ii) vw[ii] = __builtin_amdgcn_raw_buffer_load_b32(prs, vvoff, srow + (unsigned)(ii * GINP * 2), 0);
                    { const int n1 = n + 1 < NCH ? n + 1 : n; const float* grow = gbuf + (size_t)(b * SEQ + (dir ? NCH - 1 - n1 : n1) * CH + r) * 32 + dir * 16 + 8 * hh;
                      gna = *(const f32x4*)grow; gnb = *(const f32x4*)(grow + 4); }
                    {
                        u32x4 ah, al;
                        ah.x = pk2(ga[0], ga[1]); ah.y = pk2(ga[2], ga[3]); ah.z = pk2(gb[0], gb[1]); ah.w = pk2(gb[2], gb[3]);
                        al.x = pk2(ga[0] - bflo(ah.x), ga[1] - bfhi(ah.x)); al.y = pk2(ga[2] - bflo(ah.y), ga[3] - bfhi(ah.y));
                        al.z = pk2(gb[0] - bflo(ah.z), gb[1] - bfhi(ah.z)); al.w = pk2(gb[2] - bflo(ah.w), gb[3] - bfhi(ah.w));
                        const bf16x8 gah = __builtin_bit_cast(bf16x8, ah), gal = __builtin_bit_cast(bf16x8, al);
                        f32x16 zacc;
#pragma unroll
                        for (int i = 0; i < 16; ++i) zacc[i] = zbias;
                        zacc = MFMA32(gah, wbh, zacc); zacc = MFMA32(gal, wbh, zacc); zacc = MFMA32(gah, wbl, zacc);
#pragma unroll
                        for (int i = 0; i < 16; ++i) *(LAS float*)(lds + G2_Z + (((i & 3) + 8 * (i >> 2) + 4 * hh) * 128 + 32 * zd + r) * 4) = zacc[i];
                    }
                    G2_BAR();
                    float cs[16];
#pragma unroll
                    for (int ii = 0; ii < 16; ++ii) {
                        const float z = *(const LAS float*)(lds + G2_Z + ((16 * seg + ii) * 128 + d) * 4);
                        cs[ii] = fminf(z, 0.f) * (1.4426950408889634f / 16.f) - __builtin_amdgcn_logf(1.f + __builtin_amdgcn_exp2f(fabsf(z) * -1.4426950408889634f)) * (1.f / 16.f);
                    }
                    if (dir == 0) {
#pragma unroll
                        for (int ii = 1; ii < 16; ++ii) cs[ii] += cs[ii - 1];
                        *(LAS float*)(lds + G2_SEG + (seg * 128 + d) * 4) = cs[15];
                    } else {
#pragma unroll
                        for (int ii = 14; ii >= 0; --ii) cs[ii] += cs[ii + 1];
                        *(LAS float*)(lds + G2_SEG + (seg * 128 + d) * 4) = cs[0];
                    }
                    G2_BAR();
                    {
                        const float t0 = *(const LAS float*)(lds + G2_SEG + d * 4), t1 = *(const LAS float*)(lds + G2_SEG + (128 + d) * 4);
                        const float prefix = dir == 0 ? (seg ? t0 : 0.f) : (seg ? 0.f : t1);
                        const float ebl = __builtin_amdgcn_exp2f(t0 + t1);
                        unsigned kd[8];
#pragma unroll
                        for (int ii = 0; ii < 16; ii += 2) {
                            const float e0 = __builtin_amdgcn_exp2f(prefix + cs[ii]), e1 = __builtin_amdgcn_exp2f(prefix + cs[ii + 1]);
                            const float q0 = bf2f(qv[ii]), q1 = bf2f(qv[ii + 1]);
                            const float k0 = bf2f(kv[ii]) * __builtin_amdgcn_rcpf(e0), k1 = bf2f(kv[ii + 1]) * __builtin_amdgcn_rcpf(e1);
                            const unsigned qd = pk2(q0 * e0, q1 * e1);
                            const unsigned ki = pk2(k0, k1);
                            kd[ii >> 1] = pk2(k0 * ebl, k1 * ebl);
                            const int i0 = 16 * seg + ii;
                            *(LAS unsigned short*)(set + G2_QD + i0 * 272 + d * 2) = (unsigned short)(qd & 0xffffu);
                            *(LAS unsigned short*)(set + G2_QD + (i0 + 1) * 272 + d * 2) = (unsigned short)(qd >> 16);
                            *(LAS unsigned short*)(lds + G2_KI + i0 * 272 + d * 2) = (unsigned short)(ki & 0xffffu);
                            *(LAS unsigned short*)(lds + G2_KI + (i0 + 1) * 272 + d * 2) = (unsigned short)(ki >> 16);
                        }
                        *(LAS u32x4*)(set + G2_KDT + d * 80 + seg * 32) = (u32x4){kd[0], kd[1], kd[2], kd[3]};
                        *(LAS u32x4*)(set + G2_KDT + d * 80 + seg * 32 + 16) = (u32x4){kd[4], kd[5], kd[6], kd[7]};
                        if (seg == 0) *(LAS float*)(set + G2_EBL + d * 4) = ebl;
                        unsigned c0[8], c1[8];
#pragma unroll
                        for (int t = 0; t < 8; ++t) { const unsigned a_ = vw[2 * t], b_ = vw[2 * t + 1]; c0[t] = (a_ & 0xffffu) | (b_ << 16); c1[t] = (a_ >> 16) | (b_ & 0xffff0000u); }
                        *(LAS u32x4*)(set + G2_VT + (2 * d) * 80 + seg * 32) = (u32x4){c0[0], c0[1], c0[2], c0[3]};
                        *(LAS u32x4*)(set + G2_VT + (2 * d) * 80 + seg * 32 + 16) = (u32x4){c0[4], c0[5], c0[6], c0[7]};
                        *(LAS u32x4*)(set + G2_VT + (2 * d + 1) * 80 + seg * 32) = (u32x4){c1[0], c1[1], c1[2], c1[3]};
                        *(LAS u32x4*)(set + G2_VT + (2 * d + 1) * 80 + seg * 32 + 16) = (u32x4){c1[4], c1[5], c1[6], c1[7]};
                    }
                    G2_BAR();
                    {
                        const int ti = wave >> 1, tj = wave & 1;
                        f32x4 a4 = (f32x4){0.f, 0.f, 0.f, 0.f};
#pragma unroll
                        for (int ks = 0; ks < 4; ++ks) {
                            const bf16x8 ka = *(const LAS bf16x8*)(lds + G2_KI + (16 * tj + fr) * 272 + ks * 64 + fq * 16);
                            const bf16x8 qb = *(const LAS bf16x8*)(set + G2_QD + (16 * ti + fr) * 272 + ks * 64 + fq * 16);
                            a4 = MFMA16(ka, qb, a4);
                        }
                        const int qi = 16 * ti + fr, kj = 16 * tj + 4 * fq;
                        float m[4];
#pragma unroll
                        for (int e = 0; e < 4; ++e) { const bool keep = dir ? (kj + e > qi) : (kj + e <= qi); m[e] = keep ? a4[e] : 0.f; }
                        u32x2 w; w.x = pk2(m[0], m[1]); w.y = pk2(m[2], m[3]);
                        *(LAS u32x2*)(set + G2_SC + qi * 80 + kj * 2) = w;
                    }
                    G2_BAR();
                } else { G2_BAR(); G2_BAR(); G2_BAR(); G2_BAR(); }
            }
        } else {
            const int cw = wave - 4;
            bf16_t* ob = dir ? ob1 : ob0;
            const __amdgpu_buffer_rsrc_t ors = __builtin_amdgcn_make_buffer_rsrc((void*)ob, 0, (unsigned)((size_t)MTOK * DM * 2), 0x00020000);
            const unsigned ovoff = (unsigned)((r * DM + h * 256 + 64 * cw + 4 * hh) * 2);
            f32x16 S[2][4];
#pragma unroll
            for (int nt2 = 0; nt2 < 2; ++nt2)
#pragma unroll
                for (int kt = 0; kt < 4; ++kt)
#pragma unroll
                    for (int i = 0; i < 16; ++i) S[nt2][kt][i] = 0.f;
            for (int n = 0; n <= NCH; ++n) {
                if (n >= 1) {
                    const int mch = n - 1;
                    const int tok0 = b * SEQ + (dir ? NCH - 1 - mch : mch) * CH;
                    const LAS unsigned char* set = lds + (mch & 1) * G2_SET;
                    bf16x8 bv[2][2];
#pragma unroll
                    for (int nt2 = 0; nt2 < 2; ++nt2)
#pragma unroll
                        for (int ks = 0; ks < 2; ++ks) bv[nt2][ks] = *(const LAS bf16x8*)(set + G2_VT + (64 * cw + 32 * nt2 + r) * 80 + ks * 32 + hh * 16);
                    f32x16 oacc[2];
#pragma unroll
                    for (int nt2 = 0; nt2 < 2; ++nt2)
#pragma unroll
                        for (int i = 0; i < 16; ++i) oacc[nt2][i] = 0.f;
#pragma unroll
                    for (int ks = 0; ks < 2; ++ks) {
                        const bf16x8 a = *(const LAS bf16x8*)(set + G2_SC + r * 80 + ks * 32 + hh * 16);
#pragma unroll
                        for (int nt2 = 0; nt2 < 2; ++nt2) oacc[nt2] = MFMA32(bv[nt2][ks], a, oacc[nt2]);
                    }
#define G2_OINTER(KT) do { _Pragma("unroll") for (int s = 0; s < 2; ++s) { __builtin_amdgcn_sched_barrier(0); \
                        const s16x4 lo = *(const LAS s16x4*)(set + G2_QD + r * 272 + (KT) * 64 + s * 32 + hh * 8); \
                        const s16x4 hi = *(const LAS s16x4*)(set + G2_QD + r * 272 + (KT) * 64 + s * 32 + hh * 8 + 16); \
                        const bf16x8 a = __builtin_shufflevector(lo, hi, 0, 1, 2, 3, 4, 5, 6, 7); \
                        _Pragma("unroll") for (int nt2 = 0; nt2 < 2; ++nt2) { u32x4 sp; \
                            sp.x = pk2(S[nt2][KT][8 * s + 0], S[nt2][KT][8 * s + 1]); sp.y = pk2(S[nt2][KT][8 * s + 2], S[nt2][KT][8 * s + 3]); \
                            sp.z = pk2(S[nt2][KT][8 * s + 4], S[nt2][KT][8 * s + 5]); sp.w = pk2(S[nt2][KT][8 * s + 6], S[nt2][KT][8 * s + 7]); \
                            oacc[nt2] = MFMA32(__builtin_bit_cast(bf16x8, sp), a, oacc[nt2]); } } } while (0)
                    G2_OINTER(0);
                    G2_BAR();
                    G2_OINTER(1); G2_OINTER(2);
                    G2_BAR();
                    G2_OINTER(3);
                    {
                        const unsigned orow = (unsigned)tok0 * (unsigned)(DM * 2);
#pragma unroll
                        for (int nt2 = 0; nt2 < 2; ++nt2)
#pragma unroll
                            for (int g = 0; g < 4; ++g) {
                                u32x2 w; w.x = pk2(oacc[nt2][4 * g], oacc[nt2][4 * g + 1]); w.y = pk2(oacc[nt2][4 * g + 2], oacc[nt2][4 * g + 3]);
                                __builtin_amdgcn_raw_buffer_store_b64(w, ors, ovoff + (unsigned)((32 * nt2 + 8 * g) * 2), orow, 0);
                            }
                    }
#define G2_STATE(KT) do { \
                        _Pragma("unroll") for (int g4 = 0; g4 < 4; ++g4) { const f32x4 e4 = *(const LAS f32x4*)(set + G2_EBL + (32 * (KT) + 8 * g4 + 4 * hh) * 4); \
                            _Pragma("unroll") for (int nt2 = 0; nt2 < 2; ++nt2) _Pragma("unroll") for (int e = 0; e < 4; ++e) S[nt2][KT][4 * g4 + e] *= e4[e]; } \
                        _Pragma("unroll") for (int ks = 0; ks < 2; ++ks) { const bf16x8 a = *(const LAS bf16x8*)(set + G2_KDT + (32 * (KT) + r) * 80 + ks * 32 + hh * 16); \
                            _Pragma("unroll") for (int nt2 = 0; nt2 < 2; ++nt2) S[nt2][KT] = MFMA32(a, bv[nt2][ks], S[nt2][KT]); } } while (0)
                    G2_STATE(0); G2_STATE(1);
                    G2_BAR();
                    G2_STATE(2); G2_STATE(3);
#undef G2_STATE
                    G2_BAR();
#undef G2_OINTER
                } else { G2_BAR(); G2_BAR(); G2_BAR(); G2_BAR(); }
            }
        }
        G2_BAR();
    }
}

__device__ __forceinline__ void gla_post_phase(const bf16_t* ob0, const bf16_t* ob1, const bf16_t* proj, const float* hgain, bf16_t* a2) {
    int tid = threadIdx.x; asm volatile("" : "+v"(tid));
    const int lane = tid & 63, wave = __builtin_amdgcn_readfirstlane(tid >> 6);
    const int gw = blockIdx.x * NWAVES + wave, NGW = gridDim.x * NWAVES;
    const int hp = lane >> 5, c8 = (lane & 31) * 8;
    const f32x4 hg0 = *(const f32x4*)(hgain + c8), hg1 = *(const f32x4*)(hgain + c8 + 4);
    u32x4 a[2], b[2], rr[2];
#define POST_LOAD(row_) do { _Pragma("unroll") for (int ps = 0; ps < 2; ++ps) { const size_t off_ = (size_t)(row_) * DM + (2 * ps + hp) * 256 + c8; \
        a[ps] = *(const u32x4*)(ob0 + off_); b[ps] = *(const u32x4*)(ob1 + off_); rr[ps] = *(const u32x4*)(proj + (size_t)(row_) * GINP + 2048 + (2 * ps + hp) * 256 + c8); } } while (0)
    if (gw < MTOK) POST_LOAD(gw);
    for (int row = gw; row < MTOK; row += NGW) {
        u32x4 ca[2], cb[2], cr[2];
#pragma unroll
        for (int ps = 0; ps < 2; ++ps) { ca[ps] = a[ps]; cb[ps] = b[ps]; cr[ps] = rr[ps]; }
        if (row + NGW < MTOK) POST_LOAD(row + NGW);
#pragma unroll
        for (int ps = 0; ps < 2; ++ps) {
            float o[8];
#pragma unroll
            for (int q = 0; q < 4; ++q) { o[2 * q] = bflo(ca[ps][q]) + bflo(cb[ps][q]); o[2 * q + 1] = bfhi(ca[ps][q]) + bfhi(cb[ps][q]); }
            float ss = 0.f;
#pragma unroll
            for (int q = 0; q < 8; ++q) ss += o[q] * o[q];
#pragma unroll
            for (int sh = 1; sh < 32; sh <<= 1) ss += __shfl_xor(ss, sh);
            const float rs = rsqrtf(ss * (1.f / 256.f) + EPS);
            u32x4 w;
            w.x = pk2(o[0] * rs * hg0[0] * silu_f(bflo(cr[ps].x)), o[1] * rs * hg0[1] * silu_f(bfhi(cr[ps].x)));
            w.y = pk2(o[2] * rs * hg0[2] * silu_f(bflo(cr[ps].y)), o[3] * rs * hg0[3] * silu_f(bfhi(cr[ps].y)));
            w.z = pk2(o[4] * rs * hg1[0] * silu_f(bflo(cr[ps].z)), o[5] * rs * hg1[1] * silu_f(bfhi(cr[ps].z)));
            w.w = pk2(o[6] * rs * hg1[2] * silu_f(bflo(cr[ps].w)), o[7] * rs * hg1[3] * silu_f(bfhi(cr[ps].w)));
            *(u32x4*)(a2 + (size_t)row * DM + (2 * ps + hp) * 256 + c8) = w;
        }
    }
#undef POST_LOAD
}

__device__ __forceinline__ void final_norm_phase(float* out, const bf16_t* xb, const float* ssq, const float* gain) {
    int tid = threadIdx.x; asm volatile("" : "+v"(tid));
    const int lane = tid & 63, wave = __builtin_amdgcn_readfirstlane(tid >> 6);
    const int gw = blockIdx.x * NWAVES + wave, NGW = gridDim.x * NWAVES;
    f32x4 g[4];
#pragma unroll
    for (int j = 0; j < 2; ++j) { g[2 * j] = *(const f32x4*)(gain + 512 * j + 8 * lane); g[2 * j + 1] = *(const f32x4*)(gain + 512 * j + 8 * lane + 4); }
    u32x4 w[2]; f32x4 sq;
#define FIN_LOAD(row_) do { w[0] = *(const u32x4*)(xb + (size_t)(row_) * DM + 8 * lane); w[1] = *(const u32x4*)(xb + (size_t)(row_) * DM + 512 + 8 * lane); sq = *(const f32x4*)(ssq + (size_t)(row_) * 4); } while (0)
    if (gw < MTOK) FIN_LOAD(gw);
    for (int row = gw; row < MTOK; row += NGW) {
        const u32x4 c0 = w[0], c1 = w[1]; const float rs = rsqrtf(((sq.x + sq.y) + (sq.z + sq.w)) * (1.f / 1024.f) + EPS);
        if (row + NGW < MTOK) FIN_LOAD(row + NGW);
        float* orow = out + (size_t)row * DM + 8 * lane;
        *(f32x4*)(orow) = (f32x4){bflo(c0.x), bfhi(c0.x), bflo(c0.y), bfhi(c0.y)} * rs * g[0];
        *(f32x4*)(orow + 4) = (f32x4){bflo(c0.z), bfhi(c0.z), bflo(c0.w), bfhi(c0.w)} * rs * g[1];
        *(f32x4*)(orow + 512) = (f32x4){bflo(c1.x), bfhi(c1.x), bflo(c1.y), bfhi(c1.y)} * rs * g[2];
        *(f32x4*)(orow + 516) = (f32x4){bflo(c1.z), bfhi(c1.z), bflo(c1.w), bfhi(c1.w)} * rs * g[3];
    }
#undef FIN_LOAD
}

#define XB_TMO      128
#define XB_XCNT(j)  (256  + 64 * (j))
#define XB_XSUB(j)  (1280 + 64 * (j))
#define XB_XGEN(j)  (2304 + 64 * (j))
#define XB_TOP      3328
#define XB_TOPGEN   3392
#define XCD_BAR_WORDS 3456
#define XB_SPIN_CAP (1u << 22)
__device__ __forceinline__ unsigned xb_ld(unsigned* p)              { return __hip_atomic_load(p, __ATOMIC_RELAXED, __HIP_MEMORY_SCOPE_AGENT); }
__device__ __forceinline__ unsigned xb_add(unsigned* p, unsigned v) { return __hip_atomic_fetch_add(p, v, __ATOMIC_RELAXED, __HIP_MEMORY_SCOPE_AGENT); }
__device__ __forceinline__ unsigned xb_xcc_id() { return (unsigned)__builtin_amdgcn_s_getreg((3 << 11) | 20) & 0xFu; }
#define XB_SPIN(cond, bar) do { unsigned _sp = 0; while (cond) { __builtin_amdgcn_s_sleep(1); \
    if ((++_sp & 255u) == 0u) { if (xb_ld(&(bar)[XB_TMO])) break; if (_sp > XB_SPIN_CAP) { atomicAdd(&(bar)[XB_TMO], 1u); break; } } } } while (0)
struct XcdBarrier { unsigned* bar; unsigned x; volatile LAS unsigned* st; };
__device__ __forceinline__ XcdBarrier xcd_barrier_post(unsigned* bar, volatile LAS unsigned* st) {
    XcdBarrier b; b.bar = bar; b.x = xb_xcc_id(); b.st = st;
    if (threadIdx.x == 0) (void)xb_add(&bar[XB_XCNT(b.x)], 1u);
    return b;
}
__device__ __forceinline__ void xcd_barrier_complete(unsigned* bar, unsigned x, unsigned& nloc, unsigned& nx) {
    const unsigned G = gridDim.x * gridDim.y * gridDim.z;
    unsigned sum, cnt, mine, sp = 0u;
    for (;;) {
        sum = 0u; cnt = 0u; mine = 0u;
#pragma unroll
        for (unsigned j = 0; j < 16; ++j) { const unsigned c = xb_ld(&bar[XB_XCNT(j)]); sum += c; cnt += (c > 0u) ? 1u : 0u; mine = (j == x) ? c : mine; }
        if (sum == G) break;
        __builtin_amdgcn_s_sleep(1);
        if ((++sp & 255u) == 0u) { if (xb_ld(&bar[XB_TMO])) break; if (sp > XB_SPIN_CAP) { atomicAdd(&bar[XB_TMO], 1u); break; } }
    }
    nloc = mine > 0u ? mine : 1u; nx = cnt > 0u ? cnt : 1u;
}
__device__ __forceinline__ void xcd_barrier(const XcdBarrier& b) {
    asm volatile("s_waitcnt vmcnt(0)" ::: "memory");
    __syncthreads();
    if (threadIdx.x == 0) {
        unsigned* bar = b.bar;
        __builtin_amdgcn_s_waitcnt(0);
        unsigned nloc = b.st[0], nx = b.st[1];
        if (nloc == 0u) { xcd_barrier_complete(bar, b.x, nloc, nx); b.st[0] = nloc; b.st[1] = nx; }
        const unsigned old = xb_add(&bar[XB_XSUB(b.x)], 1u);
        const unsigned gen = old / nloc;
        if (old + 1u == (gen + 1u) * nloc) {
            __builtin_amdgcn_fence(__ATOMIC_RELEASE, "agent");
            asm volatile("s_waitcnt vmcnt(0)" ::: "memory");
            const unsigned og = xb_add(&bar[XB_TOP], 1u);
            const unsigned tg = og / nx;
            if (og + 1u == (tg + 1u) * nx) xb_add(&bar[XB_TOPGEN], 1u);
            else XB_SPIN(xb_ld(&bar[XB_TOPGEN]) == tg, bar);
            __builtin_amdgcn_fence(__ATOMIC_ACQUIRE, "agent");
            xb_add(&bar[XB_XGEN(b.x)], 1u);
            asm volatile("s_waitcnt vmcnt(0)" ::: "memory");
        } else {
            XB_SPIN(xb_ld(&bar[XB_XGEN(b.x)]) == gen, bar);
            __builtin_amdgcn_fence(__ATOMIC_ACQUIRE, "agent");
            asm volatile("s_waitcnt vmcnt(0)" ::: "memory");
        }
    }
    __syncthreads();
}

__device__ __forceinline__ void rstd_cache_reset(LAS unsigned char* lds) {
    int tid = threadIdx.x; asm volatile("" : "+v"(tid));
    if (tid < 4) ((volatile LAS int*)(lds + pg8::STAGE_BYTES + 8208))[tid] = -1;
    __syncthreads();
}
__global__ void __launch_bounds__(NTHREADS, 2) fwd_megakernel(Params p) {
    extern __shared__ __attribute__((aligned(16))) unsigned char lds_raw[];
    LAS unsigned char* lds = (LAS unsigned char*)lds_raw;
    cg::grid_group grid = cg::this_grid();
    const int G = gridDim.x, bx = blockIdx.x;
    unsigned char* ws = p.ws;
    float* ssq = (float*)(ws + WS_SSQ);
    float* gbuf = (float*)(ws + WS_GBUF);
    bf16_t* XB = (bf16_t*)(ws + WS_XB);
    bf16_t* R2 = (bf16_t*)(ws + WS_R2);
    bf16_t* OB1 = (bf16_t*)(ws + WS_OB1);
    bf16_t* OB0 = (bf16_t*)p.out;
    bf16_t* R1 = (bf16_t*)(ws + WS_R1);
    if (threadIdx.x < 2) ((volatile LAS unsigned*)(lds + 139264))[threadIdx.x] = 0u;
    __syncthreads();
    const XcdBarrier xbar = xcd_barrier_post((unsigned*)ws, (volatile LAS unsigned*)(lds + 139264));
#define GRID_SYNC() xcd_barrier(xbar)

    p0_phase(p, lds);
    grid.sync();

#pragma unroll 1
    for (int layer = 0; layer < 4; ++layer) {
        const int j = layer >> 1;
        if ((layer & 1) == 0) {
            pool_prep_phase(lds, XB, ssq, p.norm_mix + layer * DM, R2);
            GRID_SYNC();
            { pg8::Gemm g{R2, (const bf16_t*)(ws + WS_WPOOL + j * SZ_WPOOL), 256, DM, 256, 256}; pg8::StaticOrder S; S.init(MTOK, DM, G, bx);
              pg8::EpiRes E{XB, XB, ssq};
              pg8::gemm_phase<pg8::EpiRes, pg8::StaticOrder>(lds, g, S, E); }
            GRID_SYNC();
        } else {
            rstd_cache_reset(lds);
            { pg8::Gemm g{XB, (const bf16_t*)(ws + WS_WIN + j * SZ_WIN), DM, DM, DM, 0}; pg8::StaticOrder S; S.init(MTOK, GINP, G, bx);
              pg8::EpiProj E{R1, gbuf, ssq};
              pg8::gemm_phase<pg8::EpiProj, pg8::StaticOrder>(lds, g, S, E);
            }
            GRID_SYNC();
            gla_scan_phase2(lds, R1, gbuf, p.w_gate_up + (size_t)j * 2 * 16 * 512, p.b_gate + (size_t)j * 2 * 512, OB0, OB1);
            GRID_SYNC();
            gla_post_phase(OB0, OB1, R1, p.gla_head_norm + j * 256, R2);
            GRID_SYNC();
            { pg8::Gemm g{R2, (const bf16_t*)(ws + WS_WOUT + j * SZ_WOUT), DM, DM, DM, 0}; pg8::StaticOrder S; S.init(MTOK, DM, G, bx);
              pg8::EpiRes E{XB, XB, ssq};
              pg8::gemm_phase<pg8::EpiRes, pg8::StaticOrder>(lds, g, S, E); }
            GRID_SYNC();
        }
        rstd_cache_reset(lds);
        { pg8::Gemm g{XB, (const bf16_t*)(ws + WS_WGU + layer * SZ_WGU), DM, DM, DM, 0}; pg8::StaticOrder S; S.init(MTOK, NGU, G, bx);
          pg8::EpiGU E{R1, ssq};
          pg8::gemm_phase<pg8::EpiGU, pg8::StaticOrder>(lds, g, S, E);
        }
        GRID_SYNC();
        { pg8::Gemm g{R1, (const bf16_t*)(ws + WS_WD + layer * SZ_WD), DFF, DFF, DFF, 0}; pg8::StaticOrder S; S.init(MTOK, DM, G, bx); S.rev = (S.nwg % G) == 0;
          pg8::EpiRes E{XB, XB, ssq};
          pg8::gemm_phase<pg8::EpiRes, pg8::StaticOrder>(lds, g, S, E); }
        GRID_SYNC();
    }
    final_norm_phase(p.out, XB, ssq, p.norm_final);
}

extern "C" void kernel_launch(void* const* d_in, const int* in_sizes, int n_in, void* d_out, int out_size, void* d_ws, size_t ws_size, hipStream_t stream) {
    static int grid = 0;
    if (grid == 0) {
        if (n_in != 14 || in_sizes[0] != MTOK * DM || out_size != MTOK * DM || ws_size < WS_END) {
            fprintf(stderr, "kernel_launch: unexpected shapes (n_in %d, in0 %d, out %d, ws %zu, need %zu); nothing launched\n", n_in, n_in > 0 ? in_sizes[0] : -1, out_size, ws_size, (size_t)WS_END);
            grid = -1; return;
        }
        int dev = 0, cus = 0, per_cu = 0;
        (void)hipGetDevice(&dev);
        (void)hipDeviceGetAttribute(&cus, hipDeviceAttributeMultiprocessorCount, dev);
        if (hipFuncSetAttribute((const void*)fwd_megakernel, hipFuncAttributeMaxDynamicSharedMemorySize, LDS_BYTES) != hipSuccess) { fprintf(stderr, "kernel_launch: hipFuncSetAttribute failed\n"); grid = -1; return; }
        if (hipOccupancyMaxActiveBlocksPerMultiprocessor(&per_cu, (const void*)fwd_megakernel, NTHREADS, LDS_BYTES) != hipSuccess || per_cu < 1) {
            fprintf(stderr, "kernel_launch: occupancy query says %d blocks per CU; using 1\n", per_cu); per_cu = 1; (void)hipGetLastError();
        }
        grid = cus * 1;
        fprintf(stderr, "kernel_launch: grid %d (cus %d, per_cu %d)\n", grid, cus, per_cu);
    }
    if (grid < 0) return;
    if (hipMemsetAsync(d_ws, 0, 16384, stream) != hipSuccess) { fprintf(stderr, "kernel_launch: memset failed\n"); return; }
    Params p{};
    p.x = (const float*)d_in[0]; p.norm_mix = (const float*)d_in[1]; p.norm_ffn = (const float*)d_in[2]; p.norm_final = (const float*)d_in[3];
    p.w_pool = (const float*)d_in[4]; p.pool_scale = (const float*)d_in[5]; p.w_gla_in = (const float*)d_in[6]; p.w_gate_up = (const float*)d_in[7];
    p.b_gate = (const float*)d_in[8]; p.gla_head_norm = (const float*)d_in[9]; p.w_gla_out = (const float*)d_in[10]; p.w_ffn_gate = (const float*)d_in[11];
    p.w_ffn_up = (const float*)d_in[12]; p.w_ffn_down = (const float*)d_in[13];
    p.out = (float*)d_out; p.ws = (unsigned char*)d_ws;
    void* args[] = {&p};
    hipError_t e = hipLaunchCooperativeKernel((const void*)fwd_megakernel, dim3(grid), dim3(NTHREADS), args, LDS_BYTES, stream);
    if (e != hipSuccess) fprintf(stderr, "kernel_launch: cooperative launch failed: %s (grid %d)\n", hipGetErrorString(e), grid);
}
```

```cpp
#include <hip/hip_runtime.h>
#include <hip/hip_cooperative_groups.h>
#include <cstdio>
#include <cstdint>
namespace cg = cooperative_groups;

#define LAS __attribute__((address_space(3)))
typedef unsigned short bf16_t;
typedef short bf16x8 __attribute__((ext_vector_type(8)));
typedef short s16x4 __attribute__((ext_vector_type(4)));
typedef float f32x4 __attribute__((ext_vector_type(4)));
typedef float f32x16 __attribute__((ext_vector_type(16)));
typedef float f32x2 __attribute__((ext_vector_type(2)));
typedef __bf16 bf16x2_t __attribute__((ext_vector_type(2)));
typedef unsigned u32x4 __attribute__((ext_vector_type(4)));
typedef unsigned u32x2 __attribute__((ext_vector_type(2)));

constexpr int DM = 1024, BATCH = 32, SEQ = 2048, MTOK = BATCH * SEQ, DFF = 2816, NGU = 2 * DFF, GIN = 3104, GINP = 3328;
constexpr int NWAVES = 8, NTHREADS = 512;
constexpr float EPS = 1e-6f;

constexpr size_t MiB = 1u << 20;
constexpr size_t SZ_WGU = (size_t)NGU * DM * 2, SZ_WD = (size_t)DM * DFF * 2, SZ_WIN = (size_t)GINP * DM * 2, SZ_WOUT = (size_t)DM * DM * 2, SZ_WPOOL = (size_t)DM * 256 * 2;
constexpr size_t WS_WGU = 1 * MiB, WS_WD = WS_WGU + 4 * SZ_WGU, WS_WIN = WS_WD + 4 * SZ_WD, WS_WOUT = WS_WIN + 2 * SZ_WIN, WS_WPOOL = WS_WOUT + 2 * SZ_WOUT, WS_WEND = WS_WPOOL + 2 * SZ_WPOOL;
static_assert(WS_WEND <= 100 * MiB, "weights");
constexpr size_t WS_SSQ = 100 * MiB;
constexpr size_t WS_GBUF = 104 * MiB;
constexpr size_t WS_XB = 112 * MiB;
constexpr size_t WS_R2 = 240 * MiB;
constexpr size_t WS_OB1 = 368 * MiB;
constexpr size_t WS_R1 = 496 * MiB;
constexpr size_t WS_END = 912 * MiB;

constexpr int LDS_BYTES = 147456;

__device__ __forceinline__ unsigned pk2(float lo, float hi) { f32x2 v = {lo, hi}; bf16x2_t b = __builtin_convertvector(v, bf16x2_t); return __builtin_bit_cast(unsigned, b); }
__device__ __forceinline__ float bf2f(unsigned u16) { return __uint_as_float(u16 << 16); }
__device__ __forceinline__ float bflo(unsigned w) { return __uint_as_float(w << 16); }
__device__ __forceinline__ float bfhi(unsigned w) { return __uint_as_float(w & 0xffff0000u); }
__device__ __forceinline__ float wave_sum(float v) {
#pragma unroll
    for (int o = 1; o < 64; o <<= 1) v += __shfl_xor(v, o);
    return v;
}
__device__ __forceinline__ float fexp(float x) { return __builtin_amdgcn_exp2f(x * 1.4426950408889634f); }
__device__ __forceinline__ float flog(float x) { return __builtin_amdgcn_logf(x) * 0.6931471805599453f; }
__device__ __forceinline__ float silu_f(float g) { return g * __builtin_amdgcn_rcpf(1.f + __builtin_amdgcn_exp2f(g * -1.4426950408889634f)); }
__device__ __forceinline__ float row_rstd(const float* ssq, int row) {
    const f32x4 a = *(const f32x4*)(ssq + (size_t)row * 4);
    const float s = (a.x + a.y) + (a.z + a.w);
    return rsqrtf(s * (1.f / 1024.f) + EPS);
}

namespace pg8 {
constexpr int BM = 256, BK = 64, HALF = 128, HTB = HALF * BK * 2, STAGE_BYTES = 8 * HTB, NXCD = 8, WGM = 4;
__host__ __device__ __forceinline__ int lds_byte(int r, int c) { const int st = (r >> 4) * 2 + (c >> 5), rr = r & 15, cc = c & 31, ob = rr * 64 + cc * 2; return st * 1024 + (ob ^ (((ob >> 9) & 1) << 5)); }
__host__ __device__ __forceinline__ void stage_rc(int b, int& R, int& C) { const int st = b / 1024, sb = b % 1024, swz = sb ^ (((sb >> 9) & 1) << 5); R = (st >> 1) * 16 + swz / 64; C = (st & 1) * 32 + (swz % 64) / 2; }
__host__ __device__ __forceinline__ int perm32(int rho) { const int n = rho >> 4, i = rho & 15; return 8 * (i >> 2) + 4 * n + (i & 3); }

struct Unit { int pm, pn; };
struct Gemm { const bf16_t* A; const bf16_t* Bt; int K, lda, ldb, a_pn_off; };

struct StaticOrder {
    int nM, nN, nwg, G, c; bool rev = false;
    __host__ __device__ void init(int M, int N, int G_, int c_) { nM = M / BM; nN = N / BM; nwg = nM * nN; G = G_; c = c_; }
    __host__ __device__ bool next(int i, Unit& u) const {
        const int nr = (nwg + G - 1) / G; if (i >= nr) return false;
        const long L = (long)(rev ? nr - 1 - i : i) * G + c; if (L >= nwg) return false;
        int wgid = (int)L; { const int q = nwg / NXCD, r = nwg % NXCD, xcd = wgid % NXCD, off = wgid / NXCD; wgid = (xcd < r ? xcd * (q + 1) : r * (q + 1) + (xcd - r) * q) + off; }
        const int nig = WGM * nN, gid = wgid / nig, fm = gid * WGM, gsz = (nM - fm) < WGM ? (nM - fm) : WGM;
        u.pm = fm + ((wgid % nig) % gsz); u.pn = (wgid % nig) / gsz; return true;
    }
};


struct RstdState { int last_pm; f32x4 pre; };
__device__ __forceinline__ void rstd_unit_start(RstdState& st, const float* ssq, int pm, int tid) {
    if (pm != st.last_pm && tid < 256) st.pre = *(const f32x4*)(ssq + (size_t)(pm * BM + tid) * 4);
}
__device__ __forceinline__ const LAS float* rstd_panel(RstdState& st, LAS unsigned char* lds, int pm, int tid) {
    LAS float* RT = (LAS float*)(lds + STAGE_BYTES + 4096);
    if (pm != st.last_pm) {
        if (tid < 256) RT[tid] = rsqrtf(((st.pre.x + st.pre.y) + (st.pre.z + st.pre.w)) * (1.f / 1024.f) + EPS);
        asm volatile("s_waitcnt lgkmcnt(0)" ::: "memory"); __builtin_amdgcn_s_barrier(); asm volatile("" ::: "memory");
        st.last_pm = pm;
    }
    return RT;
}
struct NoState {};
struct EpiGU {
    static constexpr bool PERM = true; typedef RstdState State;
    __device__ __forceinline__ void init(State& st) const { st.last_pm = -1; st.pre = (f32x4){0.f, 0.f, 0.f, 0.f}; }
    __device__ __forceinline__ void unit_start(State& st, const Unit& u, int tid) const { rstd_unit_start(st, ssq, u.pm, tid); }
    bf16_t* H; const float* ssq;
    __device__ __forceinline__ void operator()(const f32x4 (&acc)[2][2][4][2], const Unit& u, int wr, int wc, int fr, int fq, LAS unsigned char* lds, int tid, State& st) const {
        const int row0 = u.pm * BM + wr * 64 + fr, col0 = u.pn * 128 + wc * 32 + 8 * fq;
        const LAS float* RT = rstd_panel(st, lds, u.pm, tid);
#pragma unroll
        for (int ai = 0; ai < 2; ++ai) {
            float rs[4];
#pragma unroll
            for (int m = 0; m < 4; ++m) rs[m] = RT[wr * 64 + fr + ai * HALF + m * 16];
#pragma unroll
            for (int m = 0; m < 4; ++m) {
                const int row = row0 + ai * HALF + m * 16; const float r = rs[m];
                const f32x4 g0 = acc[ai][0][m][0] * r, g1 = acc[ai][0][m][1] * r, u0 = acc[ai][1][m][0] * r, u1 = acc[ai][1][m][1] * r;
                u32x4 w;
                w.x = pk2(silu_f(g0[0]) * u0[0], silu_f(g0[1]) * u0[1]); w.y = pk2(silu_f(g0[2]) * u0[2], silu_f(g0[3]) * u0[3]);
                w.z = pk2(silu_f(g1[0]) * u1[0], silu_f(g1[1]) * u1[1]); w.w = pk2(silu_f(g1[2]) * u1[2], silu_f(g1[3]) * u1[3]);
                *(u32x4*)(H + (size_t)row * DFF + col0) = w;
            }
        }
    }
};
struct EpiProj {
    static constexpr bool PERM = true; typedef RstdState State;
    __device__ __forceinline__ void init(State& st) const { st.last_pm = -1; st.pre = (f32x4){0.f, 0.f, 0.f, 0.f}; }
    __device__ __forceinline__ void unit_start(State& st, const Unit& u, int tid) const { rstd_unit_start(st, ssq, u.pm, tid); }
    bf16_t* P; float* gbuf; const float* ssq;
    __device__ __forceinline__ void operator()(const f32x4 (&acc)[2][2][4][2], const Unit& u, int wr, int wc, int fr, int fq, LAS unsigned char* lds, int tid, State& st) const {
        const int row0 = u.pm * BM + wr * 64 + fr, col0 = u.pn * BM + wc * 32 + 8 * fq;
        const bool gate = (u.pn == 12) && (wc == 0);
        const LAS float* RT = rstd_panel(st, lds, u.pm, tid);
#pragma unroll
        for (int ai = 0; ai < 2; ++ai) {
            float rs[4];
#pragma unroll
            for (int m = 0; m < 4; ++m) rs[m] = RT[wr * 64 + fr + ai * HALF + m * 16];
#pragma unroll
            for (int m = 0; m < 4; ++m) {
                const int row = row0 + ai * HALF + m * 16; const float r = rs[m];
#pragma unroll
                for (int bj = 0; bj < 2; ++bj) {
                    const f32x4 v0 = acc[ai][bj][m][0] * r, v1 = acc[ai][bj][m][1] * r;
                    u32x4 w; w.x = pk2(v0[0], v0[1]); w.y = pk2(v0[2], v0[3]); w.z = pk2(v1[0], v1[1]); w.w = pk2(v1[2], v1[3]);
                    *(u32x4*)(P + (size_t)row * GINP + col0 + bj * HALF) = w;
                    if (bj == 0 && gate) { float* gp = gbuf + (size_t)row * 32 + 8 * fq; *(f32x4*)gp = v0; *(f32x4*)(gp + 4) = v1; }
                }
            }
        }
    }
};
struct EpiRes {
    static constexpr bool PERM = true; typedef NoState State;
    __device__ __forceinline__ void init(State&) const {}
    __device__ __forceinline__ void unit_start(State&, const Unit&, int) const {}
    const bf16_t* xin; bf16_t* xb; float* ssq;
    __device__ __forceinline__ void operator()(const f32x4 (&acc)[2][2][4][2], const Unit& u, int wr, int wc, int fr, int fq, LAS unsigned char* lds, int tid, State& st) const {
        const int col0 = u.pn * BM + wc * 32 + 8 * fq;
        LAS float* RED = (LAS float*)(lds + STAGE_BYTES);
#pragma unroll
        for (int ai = 0; ai < 2; ++ai) {
            u32x4 bw[4][2];
#pragma unroll
            for (int m = 0; m < 4; ++m)
#pragma unroll
                for (int bj = 0; bj < 2; ++bj) bw[m][bj] = *(const u32x4*)(xin + (size_t)(u.pm * BM + ai * HALF + wr * 64 + m * 16 + fr) * DM + col0 + bj * HALF);
#pragma unroll
            for (int m = 0; m < 4; ++m) {
                const int rl = ai * HALF + wr * 64 + m * 16 + fr;
                bf16_t* xp = xb + (size_t)(u.pm * BM + rl) * DM + col0;
                float sq = 0.f;
#pragma unroll
                for (int bj = 0; bj < 2; ++bj) {
                    const u32x4 w0 = bw[m][bj];
                    const f32x4 o0 = (f32x4){bflo(w0.x), bfhi(w0.x), bflo(w0.y), bfhi(w0.y)} + acc[ai][bj][m][0];
                    const f32x4 o1 = (f32x4){bflo(w0.z), bfhi(w0.z), bflo(w0.w), bfhi(w0.w)} + acc[ai][bj][m][1];
                    sq += ((o0[0] * o0[0] + o0[1] * o0[1]) + (o0[2] * o0[2] + o0[3] * o0[3])) + ((o1[0] * o1[0] + o1[1] * o1[1]) + (o1[2] * o1[2] + o1[3] * o1[3]));
                    u32x4 w; w.x = pk2(o0[0], o0[1]); w.y = pk2(o0[2], o0[3]); w.z = pk2(o1[0], o1[1]); w.w = pk2(o1[2], o1[3]);
                    *(u32x4*)(xp + bj * HALF) = w;
                }
                sq += __shfl_xor(sq, 16); sq += __shfl_xor(sq, 32);
                if (fq == 0) RED[wc * 256 + rl] = sq;
            }
        }
        asm volatile("s_waitcnt lgkmcnt(0)" ::: "memory"); __builtin_amdgcn_s_barrier(); asm volatile("" ::: "memory");
        if (tid < 256) ssq[(size_t)(u.pm * BM + tid) * 4 + u.pn] = (RED[tid] + RED[256 + tid]) + (RED[512 + tid] + RED[768 + tid]);
    }
};

template <class Epi, class Sched>
__device__ __forceinline__ void gemm_phase(LAS unsigned char* lds, const Gemm g, const Sched& S, const Epi& E) {
    int tid = threadIdx.x; asm volatile("" : "+v"(tid));
    const int wid = __builtin_amdgcn_readfirstlane(tid >> 6), lane = tid & 63, wr = wid >> 2, wc = wid & 3, fr = lane & 15, fq = lane >> 4;
    const int K = g.K, nt = K / BK;
    unsigned voffA[2], voffB[2];
#pragma unroll
    for (int i = 0; i < 2; ++i) { int R, C; stage_rc(tid * 16 + i * 8192, R, C); const int Rb = Epi::PERM ? ((R & ~31) + perm32(R & 31)) : R;
        voffA[i] = (unsigned)(R * g.lda + C) * 2u; voffB[i] = (unsigned)(Rb * g.ldb + C) * 2u; }
    const size_t kstep = (size_t)(BK * 2);
    const size_t hstepA = (size_t)HALF * g.lda * 2, hstepB = (size_t)HALF * g.ldb * 2;
    const size_t tstepA = 2 * hstepA, tstepB = 2 * hstepB, apn = (size_t)g.a_pn_off * 2;
    const unsigned ldsw = (unsigned)wid * 1024u;
    const int aoff = lds_byte(wr * 64 + fr, fq * 8), boff = lds_byte(wc * 32 + fr, fq * 8);
#define PG8_SA(b, h) (((b) * 2 + (h)) * HTB)
#define PG8_SB(b, h) ((4 + (b) * 2 + (h)) * HTB)
#define PG8_STAGE(bufoff, gbase, voff) do { _Pragma("unroll") for (int _i = 0; _i < 2; ++_i) \
        __builtin_amdgcn_global_load_lds((const unsigned*)((const char*)(gbase) + (voff)[_i]), (LAS unsigned*)(lds + (bufoff) + ldsw + _i * 8192), 16, 0, 0); } while (0)
#define PG8_LDA(dst, b, h) do { _Pragma("unroll") for (int m = 0; m < 4; ++m) _Pragma("unroll") for (int k = 0; k < 2; ++k) dst[m][k] = *(const LAS bf16x8*)(lds + PG8_SA(b, h) + aoff + m * 2048 + k * 1024); } while (0)
#define PG8_LDB(dst, b, h) do { _Pragma("unroll") for (int n = 0; n < 2; ++n) _Pragma("unroll") for (int k = 0; k < 2; ++k) dst[n][k] = *(const LAS bf16x8*)(lds + PG8_SB(b, h) + boff + n * 2048 + k * 1024); } while (0)
#define PG8_MMA(ai, bj, At, Bt) do { __builtin_amdgcn_s_setprio(1); _Pragma("unroll") for (int m = 0; m < 4; ++m) _Pragma("unroll") for (int n = 0; n < 2; ++n) _Pragma("unroll") for (int k = 0; k < 2; ++k) \
        acc[ai][bj][m][n] = __builtin_amdgcn_mfma_f32_16x16x32_bf16(Bt[n][k], At[m][k], acc[ai][bj][m][n], 0, 0, 0); __builtin_amdgcn_s_setprio(0); } while (0)
#define PG8_WAIT_V(n) asm volatile("s_waitcnt vmcnt(" #n ")" ::: "memory")
#define PG8_WAIT_L(n) asm volatile("s_waitcnt lgkmcnt(" #n ")" ::: "memory")
#define PG8_BAR __builtin_amdgcn_s_barrier()
#define PG8_SCHED __builtin_amdgcn_sched_barrier(0)
    Unit cur, nxt; int ui = 0;
    if (!S.next(0, cur)) return;
    typename Epi::State est; E.init(est); E.unit_start(est, cur, tid);
    f32x4 acc[2][2][4][2];
#pragma unroll
    for (int a = 0; a < 2; ++a)
#pragma unroll
        for (int b = 0; b < 2; ++b)
#pragma unroll
            for (int m = 0; m < 4; ++m)
#pragma unroll
                for (int n = 0; n < 2; ++n) acc[a][b][m][n] = (f32x4){0.f, 0.f, 0.f, 0.f};
    bf16x8 At[4][2], B0[2][2], B1[2][2];
    const char* cA = (const char*)g.A + (size_t)cur.pm * tstepA + (size_t)cur.pn * apn; const char* cB = (const char*)g.Bt + (size_t)cur.pn * tstepB;
    PG8_STAGE(PG8_SB(0, 0), cB, voffB); PG8_STAGE(PG8_SB(0, 1), cB + hstepB, voffB); PG8_STAGE(PG8_SA(0, 0), cA, voffA); PG8_STAGE(PG8_SA(0, 1), cA + hstepA, voffA);
    if (wr == 1) PG8_BAR;
    PG8_WAIT_V(2); PG8_BAR;
    PG8_STAGE(PG8_SB(1, 0), cB + kstep, voffB); PG8_STAGE(PG8_SA(1, 0), cA + kstep, voffA); PG8_STAGE(PG8_SB(1, 1), cB + hstepB + kstep, voffB);
    PG8_WAIT_V(6); PG8_BAR;
    for (;;) {
        const bool has_next = S.next(ui + 1, nxt);
        const char* nA = has_next ? (const char*)g.A + (size_t)nxt.pm * tstepA + (size_t)nxt.pn * apn : cA; const char* nB = has_next ? (const char*)g.Bt + (size_t)nxt.pn * tstepB : cB;
        for (int t = 0; t < nt; t += 2) {
            const bool last = (t == nt - 2);
            const char* a1 = cA + (size_t)(t + 1) * kstep;
            const char* a2 = last ? nA : cA + (size_t)(t + 2) * kstep; const char* b2 = last ? nB : cB + (size_t)(t + 2) * kstep;
            const char* a3 = a2 + kstep; const char* b3 = b2 + kstep;
            PG8_LDB(B0, 0, 0); PG8_LDB(B1, 0, 1); PG8_SCHED; PG8_LDA(At, 0, 0); PG8_STAGE(PG8_SA(1, 1), a1 + hstepA, voffA);
            PG8_WAIT_V(8); PG8_WAIT_L(0); PG8_BAR; PG8_MMA(0, 0, At, B0); PG8_MMA(0, 1, At, B1); PG8_BAR; PG8_SCHED;
            PG8_LDA(At, 0, 1); PG8_STAGE(PG8_SB(0, 0), b2, voffB); PG8_STAGE(PG8_SB(0, 1), b2 + hstepB, voffB); PG8_STAGE(PG8_SA(0, 0), a2, voffA);
            PG8_WAIT_V(8); PG8_WAIT_L(0); PG8_BAR; PG8_MMA(1, 0, At, B0); PG8_MMA(1, 1, At, B1); PG8_BAR; PG8_SCHED;
            PG8_LDB(B0, 1, 0); PG8_LDB(B1, 1, 1); PG8_SCHED; PG8_LDA(At, 1, 0); PG8_STAGE(PG8_SA(0, 1), a2 + hstepA, voffA);
            PG8_WAIT_V(8); PG8_WAIT_L(0); PG8_BAR; PG8_MMA(0, 0, At, B0); PG8_MMA(0, 1, At, B1); PG8_BAR; PG8_SCHED;
            PG8_LDA(At, 1, 1); PG8_STAGE(PG8_SB(1, 0), b3, voffB); PG8_STAGE(PG8_SB(1, 1), b3 + hstepB, voffB); PG8_STAGE(PG8_SA(1, 0), a3, voffA);
            PG8_WAIT_V(8); PG8_WAIT_L(0); PG8_BAR; PG8_MMA(1, 0, At, B0); PG8_MMA(1, 1, At, B1); PG8_BAR; PG8_SCHED;
        }
        if (wr == 0) PG8_BAR;
        E(acc, cur, wr, wc, fr, fq, lds, tid, est);
        if (!has_next) break;
#pragma unroll
        for (int a = 0; a < 2; ++a)
#pragma unroll
            for (int b = 0; b < 2; ++b)
#pragma unroll
                for (int m = 0; m < 4; ++m)
#pragma unroll
                    for (int n = 0; n < 2; ++n) acc[a][b][m][n] = (f32x4){0.f, 0.f, 0.f, 0.f};
        cur = nxt; cA = nA; cB = nB; ++ui;
        E.unit_start(est, cur, tid);
        if (wr == 1) PG8_BAR;
    }
    PG8_WAIT_V(0);
    PG8_BAR;
#undef PG8_SA
#undef PG8_SB
#undef PG8_STAGE
#undef PG8_LDA
#undef PG8_LDB
#undef PG8_MMA
#undef PG8_WAIT_V
#undef PG8_WAIT_L
#undef PG8_BAR
#undef PG8_SCHED
}
}

struct Params {
    const float* x; const float* norm_mix; const float* norm_ffn; const float* norm_final;
    const float* w_pool; const float* pool_scale; const float* w_gla_in; const float* w_gate_up; const float* b_gate;
    const float* gla_head_norm; const float* w_gla_out; const float* w_ffn_gate; const float* w_ffn_up; const float* w_ffn_down;
    float* out; unsigned char* ws;
};

struct P0Item { const float* W; bf16_t* WT; const float* kscale; const float* nscale; int N, ldt, k0, n0, drow0; float cscale; };
__device__ __forceinline__ P0Item p0_decode(const Params& p, int it) {
    constexpr int I_G = (DM / 64) * (DFF / 32), I_D = (DFF / 64) * (DM / 32), I_L = 2 * I_G + I_D;
    constexpr int I_IN = (DM / 64) * (GIN / 32), I_OUT = (DM / 64) * (DM / 32), I_J = I_IN + I_OUT;
    constexpr int I_P = (256 / 64) * (256 / 32);
    unsigned char* ws = p.ws; P0Item q; int r = it;
    if (r < 4 * I_L) {
        const int l = r / I_L; r -= l * I_L;
        if (r < 2 * I_G) {
            const int up = r / I_G; r -= up * I_G;
            const int nb = r % (DFF / 32), kb = r / (DFF / 32), n0 = nb * 32;
            q.W = (up ? p.w_ffn_up : p.w_ffn_gate) + (size_t)l * DM * DFF; q.N = DFF; q.WT = (bf16_t*)(ws + WS_WGU + l * SZ_WGU); q.ldt = DM; q.k0 = kb * 64; q.n0 = n0;
            q.drow0 = (n0 >> 7) * 256 + up * 128 + (n0 & 127); q.kscale = p.norm_ffn + l * DM; q.nscale = nullptr; q.cscale = 1.f;
        } else {
            r -= 2 * I_G;
            const int nb = r % (DM / 32), kb = r / (DM / 32), n0 = nb * 32;
            q.W = p.w_ffn_down + (size_t)l * DFF * DM; q.N = DM; q.WT = (bf16_t*)(ws + WS_WD + l * SZ_WD); q.ldt = DFF; q.k0 = kb * 64; q.n0 = n0; q.drow0 = n0; q.kscale = nullptr; q.nscale = nullptr; q.cscale = 1.f;
        }
        return q;
    }
    r -= 4 * I_L;
    if (r < 2 * I_J) {
        const int j = r / I_J; r -= j * I_J;
        if (r < I_IN) {
            const int nb = r % (GIN / 32), kb = r / (GIN / 32), n0 = nb * 32;
            q.W = p.w_gla_in + (size_t)j * DM * GIN; q.N = GIN; q.WT = (bf16_t*)(ws + WS_WIN + j * SZ_WIN); q.ldt = DM; q.k0 = kb * 64; q.n0 = n0; q.drow0 = n0;
            q.kscale = p.norm_mix + (2 * j + 1) * DM; q.nscale = nullptr; q.cscale = n0 < 512 ? 0.08838834764831845f : 1.f;
        } else {
            r -= I_IN;
            const int nb = r % (DM / 32), kb = r / (DM / 32), n0 = nb * 32;
            q.W = p.w_gla_out + (size_t)j * DM * DM; q.N = DM; q.WT = (bf16_t*)(ws + WS_WOUT + j * SZ_WOUT); q.ldt = DM; q.k0 = kb * 64; q.n0 = n0; q.drow0 = n0; q.kscale = nullptr; q.nscale = nullptr; q.cscale = 1.f;
        }
        return q;
    }
    r -= 2 * I_J;
    {
        const int jg = r / I_P; r -= jg * I_P; const int j = jg >> 2, g = jg & 3;
        const int nb = r % 8, kb = r / 8, n0 = nb * 32;
        q.W = p.w_pool + (size_t)jg * 256 * 256; q.N = 256; q.WT = (bf16_t*)(ws + WS_WPOOL + j * SZ_WPOOL); q.ldt = 256; q.k0 = kb * 64; q.n0 = n0; q.drow0 = g * 256 + n0;
        q.kscale = nullptr; q.nscale = p.pool_scale + j * DM + g * 256; q.cscale = 1.f;
    }
    return q;
}
__device__ __forceinline__ void p0_load(const P0Item& q, int lane, float (&v)[32]) {
#pragma unroll
    for (int i = 0; i < 32; ++i) { const int kk = 2 * i + (lane >> 5); v[i] = q.W[(size_t)(q.k0 + kk) * q.N + q.n0 + (lane & 31)]; }
}
__device__ __forceinline__ void p0_finish(const P0Item& q, LAS float* scr, int lane, const float (&v)[32]) {
#pragma unroll
    for (int i = 0; i < 32; ++i) { const int kk = 2 * i + (lane >> 5); scr[kk * 33 + (lane & 31)] = v[i]; }
    asm volatile("s_waitcnt lgkmcnt(0)" ::: "memory");
    const int c = lane & 7;
    f32x4 ka = (f32x4){1.f, 1.f, 1.f, 1.f}, kb = ka;
    if (q.kscale) { ka = *(const f32x4*)(q.kscale + q.k0 + 8 * c); kb = *(const f32x4*)(q.kscale + q.k0 + 8 * c + 4); }
#pragma unroll
    for (int j = 0; j < 4; ++j) { const int n = (lane >> 3) + 8 * j; const LAS float* s = scr + (8 * c) * 33 + n;
        const float ns = (q.nscale ? q.nscale[q.n0 + n] : 1.f) * q.cscale;
        u32x4 o; o.x = pk2(s[0 * 33] * ka[0] * ns, s[1 * 33] * ka[1] * ns); o.y = pk2(s[2 * 33] * ka[2] * ns, s[3 * 33] * ka[3] * ns);
        o.z = pk2(s[4 * 33] * kb[0] * ns, s[5 * 33] * kb[1] * ns); o.w = pk2(s[6 * 33] * kb[2] * ns, s[7 * 33] * kb[3] * ns);
        *(u32x4*)(q.WT + (size_t)(q.drow0 + n) * q.ldt + q.k0 + 8 * c) = o; }
    asm volatile("s_waitcnt lgkmcnt(0)" ::: "memory");
}

__device__ __forceinline__ void p0_phase(const Params& p, LAS unsigned char* lds) {
    int tid = threadIdx.x; asm volatile("" : "+v"(tid));
    const int lane = tid & 63, wave = __builtin_amdgcn_readfirstlane(tid >> 6);
    LAS float* scr = (LAS float*)(lds + wave * 16384);
    const int gw = blockIdx.x * NWAVES + wave, NGW = gridDim.x * NWAVES;
    constexpr int NITEMS = 4 * (2 * (DM / 64) * (DFF / 32) + (DFF / 64) * (DM / 32)) + 2 * ((DM / 64) * (GIN / 32) + (DM / 64) * (DM / 32)) + 8 * (256 / 64) * (256 / 32);
    unsigned char* ws = p.ws;
    if (gw < NITEMS) {
        P0Item cur = p0_decode(p, gw); float v[32]; p0_load(cur, lane, v);
        for (int it = gw; it < NITEMS; it += NGW) {
            const int nit = it + NGW < NITEMS ? it + NGW : it;
            const P0Item nxt = p0_decode(p, nit); float vn[32]; p0_load(nxt, lane, vn);
            p0_finish(cur, scr, lane, v);
            cur = nxt;
#pragma unroll
            for (int i = 0; i < 32; ++i) v[i] = vn[i];
        }
    }
    for (int e = gw * 64 + lane; e < 2 * (GINP - GIN) * DM / 8; e += NGW * 64) {
        const int j = e / ((GINP - GIN) * DM / 8), q = e % ((GINP - GIN) * DM / 8);
        *(u32x4*)(ws + WS_WIN + j * SZ_WIN + (size_t)GIN * DM * 2 + (size_t)q * 16) = (u32x4){0u, 0u, 0u, 0u};
    }
    float* ssq = (float*)(ws + WS_SSQ);
    {
        f32x4 v[4];
#define P0_LOAD(row_) do { const f32x4* xr_ = (const f32x4*)(p.x + (size_t)(row_) * DM) + lane; _Pragma("unroll") for (int j = 0; j < 4; ++j) v[j] = xr_[64 * j]; } while (0)
        if (gw < MTOK) P0_LOAD(gw);
        for (int row = gw; row < MTOK; row += NGW) {
            f32x4 c[4];
#pragma unroll
            for (int j = 0; j < 4; ++j) c[j] = v[j];
            if (row + NGW < MTOK) P0_LOAD(row + NGW);
            float s = 0.f;
            u32x2* xo = (u32x2*)(ws + WS_XB + (size_t)row * DM * 2) + lane;
#pragma unroll
            for (int j = 0; j < 4; ++j) { s += (c[j].x * c[j].x + c[j].y * c[j].y) + (c[j].z * c[j].z + c[j].w * c[j].w); u32x2 w; w.x = pk2(c[j].x, c[j].y); w.y = pk2(c[j].z, c[j].w); xo[64 * j] = w; }
            s = wave_sum(s);
            if (lane < 4) ssq[(size_t)row * 4 + lane] = lane == 0 ? s : 0.f;
        }
#undef P0_LOAD
    }
}

__device__ __forceinline__ void pool_prep_phase(LAS unsigned char* lds, const bf16_t* x, const float* ssq, const float* gain, bf16_t* mixed) {
    int tid = threadIdx.x; asm volatile("" : "+v"(tid));
    LAS float* HT = (LAS float*)lds; LAS float* RS = (LAS float*)(lds + 81920);
    const int nitems = MTOK / 64;
    const int nit = (int)blockIdx.x < nitems ? (nitems - (int)blockIdx.x + (int)gridDim.x - 1) / (int)gridDim.x : 0;
    const int nsteps = nit * 4;
    u32x2 raw[10];
#define PP_GEO(st_) const int g_ = (st_) & 3, tok0_ = ((int)blockIdx.x + ((st_) >> 2) * (int)gridDim.x) * 64, s0_ = tok0_ & (SEQ - 1); \
        const int win_ = 2 << g_, left_ = win_ >> 1, right_ = win_ - 1 - left_, rlo_ = 8 - left_, nrows_ = 64 + left_ + right_;
#define PP_LOAD(st_) do { PP_GEO(st_) _Pragma("unroll") for (int k = 0; k < 10; ++k) { const int e = tid + k * NTHREADS; raw[k] = (u32x2){0u, 0u}; \
        if (e < nrows_ * 64) { const int rr = rlo_ + (e >> 6), c4 = e & 63, pos = s0_ - 8 + rr; \
            if (pos >= 0 && pos < SEQ) raw[k] = *(const u32x2*)(x + (size_t)(tok0_ - 8 + rr) * DM + g_ * 256 + c4 * 4); } } } while (0)
    if (nsteps > 0) PP_LOAD(0);
    for (int st = 0; st < nsteps; ++st) {
        PP_GEO(st)
        if (g_ == 0) {
            if (tid < 79) { const int pos = s0_ - 8 + tid; float r = 0.f; if (pos >= 0 && pos < SEQ) r = row_rstd(ssq, tok0_ - 8 + tid); RS[tid] = r; }
            __syncthreads();
        }
#pragma unroll
        for (int k = 0; k < 10; ++k) {
            const int e = tid + k * NTHREADS;
            if (e < nrows_ * 64) { const int rr = rlo_ + (e >> 6), c4 = e & 63; const u32x2 w = raw[k];
                *(LAS f32x4*)(HT + rr * 256 + c4 * 4) = (f32x4){bflo(w.x), bfhi(w.x), bflo(w.y), bfhi(w.y)} * RS[rr]; }
        }
        __syncthreads();
        if (st + 1 < nsteps) PP_LOAD(st + 1);
        {
            const int cq = tid & 63, tq = tid >> 6;
            const f32x4 gn = *(const f32x4*)(gain + g_ * 256 + cq * 4);
            const int tl0 = tq * 8;
            f32x4 sum = (f32x4){0.f, 0.f, 0.f, 0.f};
            for (int q = -left_; q <= right_; ++q) sum += *(const LAS f32x4*)(HT + (tl0 + 8 + q) * 256 + cq * 4);
#pragma unroll
            for (int tt = 0; tt < 8; ++tt) {
                const int tl = tl0 + tt, pos = s0_ + tl;
                const int lo = (pos - left_) > 0 ? (pos - left_) : 0, hi = (pos + right_ + 1) < SEQ ? (pos + right_ + 1) : SEQ;
                const f32x4 self = *(const LAS f32x4*)(HT + (tl + 8) * 256 + cq * 4);
                const f32x4 o = (sum * __builtin_amdgcn_rcpf((float)(hi - lo)) - self) * gn;
                u32x2 w; w.x = pk2(o[0], o[1]); w.y = pk2(o[2], o[3]);
                *(u32x2*)(mixed + (size_t)(tok0_ + tl) * DM + g_ * 256 + cq * 4) = w;
                if (tt < 7) { sum += *(const LAS f32x4*)(HT + (tl + 8 + right_ + 1) * 256 + cq * 4); sum -= *(const LAS f32x4*)(HT + (tl + 8 - left_) * 256 + cq * 4); }
            }
        }
        __syncthreads();
    }
#undef PP_LOAD
#undef PP_GEO
}

constexpr int GL_QD = 0, GL_KI = 17408, GL_KDT = 34816, GL_VT = 53248, GL_SC = 90112, GL_Z = 99328  , GL_SEG = 132096, GL_EBL = 134144;
#define MFMA32(a, b, c) __builtin_amdgcn_mfma_f32_32x32x16_bf16((a), (b), (c), 0, 0, 0)
#define MFMA16(a, b, c) __builtin_amdgcn_mfma_f32_16x16x32_bf16((a), (b), (c), 0, 0, 0)
__device__ __forceinline__ void gla_scan_phase(LAS unsigned char* lds, const bf16_t* proj, const float* gbuf, const float* wgu  , const float* bg  ,
                                               bf16_t* ob0, bf16_t* ob1) {
    int tid = threadIdx.x; asm volatile("" : "+v"(tid));
    const int lane = tid & 63, wave = __builtin_amdgcn_readfirstlane(tid >> 6);
    const int d = tid & 127, seg = tid >> 7;
    const int r = lane & 31, hh = lane >> 5, fr = lane & 15, fq = lane >> 4;
    for (int item = blockIdx.x; item < BATCH * 8; item += gridDim.x) {
        const int b = item >> 3, h = (item >> 1) & 3, dir = item & 1;
        bf16_t* ob = dir ? ob1 : ob0;
        const int zt = wave >> 2, zd = wave & 3;
        bf16x8 wbh, wbl;
        {
            unsigned hi_[4], lo_[4];
#pragma unroll
            for (int q = 0; q < 4; ++q) {
                const float w0 = wgu[(size_t)(dir * 16 + 8 * hh + 2 * q) * 512 + h * 128 + 32 * zd + r], w1 = wgu[(size_t)(dir * 16 + 8 * hh + 2 * q + 1) * 512 + h * 128 + 32 * zd + r];
                hi_[q] = pk2(w0, w1); lo_[q] = pk2(w0 - bflo(hi_[q]), w1 - bfhi(hi_[q]));
            }
            wbh = __builtin_bit_cast(bf16x8, (u32x4){hi_[0], hi_[1], hi_[2], hi_[3]}); wbl = __builtin_bit_cast(bf16x8, (u32x4){lo_[0], lo_[1], lo_[2], lo_[3]});
        }
        const float zbias = bg[dir * 512 + h * 128 + 32 * zd + r];
        f32x16 S[4];
#pragma unroll
        for (int kt = 0; kt < 4; ++kt)
#pragma unroll
            for (int i = 0; i < 16; ++i) S[kt][i] = 0.f;
        f32x4 gna, gnb;
        { const float* grow = gbuf + (size_t)(b * SEQ + (dir ? SEQ / 64 - 1 : 0) * 64 + 32 * zt + r) * 32 + dir * 16 + 8 * hh; gna = *(const f32x4*)grow; gnb = *(const f32x4*)(grow + 4); }
        for (int n = 0; n < SEQ / 64; ++n) {
            const int c = dir ? (SEQ / 64 - 1 - n) : n;
            const int tok0 = b * SEQ + c * 64;
            const f32x4 ga = gna, gb = gnb;
            const bf16_t* prow = proj + (size_t)(tok0 + 16 * seg) * GINP + h * 128 + d;
            unsigned short qv[16], kv[16];
#pragma unroll
            for (int ii = 0; ii < 16; ++ii) { qv[ii] = prow[(size_t)ii * GINP]; kv[ii] = prow[(size_t)ii * GINP + 512]; }
            const bf16_t* vrow = proj + (size_t)(tok0 + 16 * seg) * GINP + 1024 + h * 256 + 2 * d;
            unsigned vw[16];
#pragma unroll
            for (int ii = 0; ii < 16; ++ii) vw[ii] = *(const unsigned*)(vrow + (size_t)ii * GINP);
            {
                u32x4 ah, al;
                ah.x = pk2(ga[0], ga[1]); ah.y = pk2(ga[2], ga[3]); ah.z = pk2(gb[0], gb[1]); ah.w = pk2(gb[2], gb[3]);
                al.x = pk2(ga[0] - bflo(ah.x), ga[1] - bfhi(ah.x)); al.y = pk2(ga[2] - bflo(ah.y), ga[3] - bfhi(ah.y));
                al.z = pk2(gb[0] - bflo(ah.z), gb[1] - bfhi(ah.z)); al.w = pk2(gb[2] - bflo(ah.w), gb[3] - bfhi(ah.w));
                const bf16x8 gah = __builtin_bit_cast(bf16x8, ah), gal = __builtin_bit_cast(bf16x8, al);
                f32x16 zacc;
#pragma unroll
                for (int i = 0; i < 16; ++i) zacc[i] = zbias;
                zacc = MFMA32(gah, wbh, zacc); zacc = MFMA32(gal, wbh, zacc); zacc = MFMA32(gah, wbl, zacc);
#pragma unroll
                for (int i = 0; i < 16; ++i) *(LAS float*)(lds + GL_Z + ((32 * zt + (i & 3) + 8 * (i >> 2) + 4 * hh) * 128 + 32 * zd + r) * 4) = zacc[i];
            }
            __syncthreads();
            float cs[16];
#pragma unroll
            for (int ii = 0; ii < 16; ++ii) {
                const float z = *(const LAS float*)(lds + GL_Z + ((16 * seg + ii) * 128 + d) * 4);
                cs[ii] = fminf(z, 0.f) * (1.4426950408889634f / 16.f) - __builtin_amdgcn_logf(1.f + __builtin_amdgcn_exp2f(fabsf(z) * -1.4426950408889634f)) * (1.f / 16.f);
            }
            if (dir == 0) {
#pragma unroll
                for (int ii = 1; ii < 16; ++ii) cs[ii] += cs[ii - 1];
                *(LAS float*)(lds + GL_SEG + (seg * 128 + d) * 4) = cs[15];
            } else {
#pragma unroll
                for (int ii = 14; ii >= 0; --ii) cs[ii] += cs[ii + 1];
                *(LAS float*)(lds + GL_SEG + (seg * 128 + d) * 4) = cs[0];
            }
            __syncthreads();
            const float t0 = *(const LAS float*)(lds + GL_SEG + (0 * 128 + d) * 4), t1 = *(const LAS float*)(lds + GL_SEG + (1 * 128 + d) * 4),
                        t2 = *(const LAS float*)(lds + GL_SEG + (2 * 128 + d) * 4), t3 = *(const LAS float*)(lds + GL_SEG + (3 * 128 + d) * 4);
            const float prefix = dir == 0 ? ((seg > 0 ? t0 : 0.f) + (seg > 1 ? t1 : 0.f) + (seg > 2 ? t2 : 0.f))
                                          : ((seg < 1 ? t1 : 0.f) + (seg < 2 ? t2 : 0.f) + (seg < 3 ? t3 : 0.f));
            const float ebl = __builtin_amdgcn_exp2f((t0 + t1) + (t2 + t3));
            unsigned kd[8];
#pragma unroll
            for (int ii = 0; ii < 16; ii += 2) {
                const float e0 = __builtin_amdgcn_exp2f(prefix + cs[ii]), e1 = __builtin_amdgcn_exp2f(prefix + cs[ii + 1]);
                const float q0 = bf2f(qv[ii]), q1 = bf2f(qv[ii + 1]);
                const float k0 = bf2f(kv[ii]) * __builtin_amdgcn_rcpf(e0), k1 = bf2f(kv[ii + 1]) * __builtin_amdgcn_rcpf(e1);
                const unsigned qd = pk2(q0 * e0, q1 * e1);
                const unsigned ki = pk2(k0, k1);
                kd[ii >> 1] = pk2(k0 * ebl, k1 * ebl);
                const int i0 = 16 * seg + ii;
                *(LAS unsigned short*)(lds + GL_QD + i0 * 272 + d * 2) = (unsigned short)(qd & 0xffffu);
                *(LAS unsigned short*)(lds + GL_QD + (i0 + 1) * 272 + d * 2) = (unsigned short)(qd >> 16);
                *(LAS unsigned short*)(lds + GL_KI + i0 * 272 + d * 2) = (unsigned short)(ki & 0xffffu);
                *(LAS unsigned short*)(lds + GL_KI + (i0 + 1) * 272 + d * 2) = (unsigned short)(ki >> 16);
            }
            *(LAS u32x4*)(lds + GL_KDT + d * 144 + seg * 32) = (u32x4){kd[0], kd[1], kd[2], kd[3]};
            *(LAS u32x4*)(lds + GL_KDT + d * 144 + seg * 32 + 16) = (u32x4){kd[4], kd[5], kd[6], kd[7]};
            if (seg == 0) *(LAS float*)(lds + GL_EBL + d * 4) = ebl;
            {
                unsigned c0[8], c1[8];
#pragma unroll
                for (int t = 0; t < 8; ++t) { const unsigned a_ = vw[2 * t], b_ = vw[2 * t + 1]; c0[t] = (a_ & 0xffffu) | (b_ << 16); c1[t] = (a_ >> 16) | (b_ & 0xffff0000u); }
                *(LAS u32x4*)(lds + GL_VT + (2 * d) * 144 + seg * 32) = (u32x4){c0[0], c0[1], c0[2], c0[3]};
                *(LAS u32x4*)(lds + GL_VT + (2 * d) * 144 + seg * 32 + 16) = (u32x4){c0[4], c0[5], c0[6], c0[7]};
                *(LAS u32x4*)(lds + GL_VT + (2 * d + 1) * 144 + seg * 32) = (u32x4){c1[0], c1[1], c1[2], c1[3]};
                *(LAS u32x4*)(lds + GL_VT + (2 * d + 1) * 144 + seg * 32 + 16) = (u32x4){c1[4], c1[5], c1[6], c1[7]};
            }
            __syncthreads();
            {
                const int ti = wave >> 1;
#pragma unroll
                for (int tjj = 0; tjj < 2; ++tjj) {
                    const int tj = 2 * (wave & 1) + tjj;
                    f32x4 a4 = (f32x4){0.f, 0.f, 0.f, 0.f};
#pragma unroll
                    for (int ks = 0; ks < 4; ++ks) {
                        const bf16x8 ka = *(const LAS bf16x8*)(lds + GL_KI + (16 * tj + fr) * 272 + ks * 64 + fq * 16);
                        const bf16x8 qb = *(const LAS bf16x8*)(lds + GL_QD + (16 * ti + fr) * 272 + ks * 64 + fq * 16);
                        a4 = MFMA16(ka, qb, a4);
                    }
                    const int qi = 16 * ti + fr, kj = 16 * tj + 4 * fq;
                    float m[4];
#pragma unroll
                    for (int e = 0; e < 4; ++e) { const bool keep = dir ? (kj + e > qi) : (kj + e <= qi); m[e] = keep ? a4[e] : 0.f; }
                    u32x2 w; w.x = pk2(m[0], m[1]); w.y = pk2(m[2], m[3]);
                    *(LAS u32x2*)(lds + GL_SC + qi * 144 + kj * 2) = w;
                }
            }
            __syncthreads();
            { const int n1 = n + 1 < SEQ / 64 ? n + 1 : n; const float* grow = gbuf + (size_t)(b * SEQ + (dir ? SEQ / 64 - 1 - n1 : n1) * 64 + 32 * zt + r) * 32 + dir * 16 + 8 * hh;
              gna = *(const f32x4*)grow; gnb = *(const f32x4*)(grow + 4); }
            bf16x8 bv[4];
#pragma unroll
            for (int ks = 0; ks < 4; ++ks) bv[ks] = *(const LAS bf16x8*)(lds + GL_VT + (32 * wave + r) * 144 + ks * 32 + hh * 16);
            f32x16 oacc[2];
#pragma unroll
            for (int mt = 0; mt < 2; ++mt) {
#pragma unroll
                for (int i = 0; i < 16; ++i) oacc[mt][i] = 0.f;
#pragma unroll
                for (int ks = 0; ks < 4; ++ks) {
                    const bf16x8 a = *(const LAS bf16x8*)(lds + GL_SC + (32 * mt + r) * 144 + ks * 32 + hh * 16);
                    oacc[mt] = MFMA32(a, bv[ks], oacc[mt]);
                }
            }
#pragma unroll
            for (int kt = 0; kt < 4; ++kt)
#pragma unroll
                for (int s = 0; s < 2; ++s) {
                    u32x4 sp;
                    sp.x = pk2(S[kt][8 * s + 0], S[kt][8 * s + 1]); sp.y = pk2(S[kt][8 * s + 2], S[kt][8 * s + 3]);
                    sp.z = pk2(S[kt][8 * s + 4], S[kt][8 * s + 5]); sp.w = pk2(S[kt][8 * s + 6], S[kt][8 * s + 7]);
                    const bf16x8 sb = __builtin_bit_cast(bf16x8, sp);
#pragma unroll
                    for (int mt = 0; mt < 2; ++mt) {
                        const s16x4 lo = *(const LAS s16x4*)(lds + GL_QD + (32 * mt + r) * 272 + kt * 64 + s * 32 + hh * 8);
                        const s16x4 hi = *(const LAS s16x4*)(lds + GL_QD + (32 * mt + r) * 272 + kt * 64 + s * 32 + hh * 8 + 16);
                        const bf16x8 a = __builtin_shufflevector(lo, hi, 0, 1, 2, 3, 4, 5, 6, 7);
                        oacc[mt] = MFMA32(a, sb, oacc[mt]);
                    }
                }
            {
                bf16_t* obase = ob + (size_t)(tok0 + 4 * hh) * DM + h * 256 + 32 * wave + r;
#pragma unroll
                for (int mt = 0; mt < 2; ++mt)
#pragma unroll
                    for (int i = 0; i < 16; ++i) {
                        const int row = 32 * mt + (i & 3) + 8 * (i >> 2);
                        obase[(size_t)row * DM] = (bf16_t)(pk2(oacc[mt][i], 0.f) & 0xffffu);
                    }
            }
#pragma unroll
            for (int kt = 0; kt < 4; ++kt) {
#pragma unroll
                for (int g4 = 0; g4 < 4; ++g4) {
                    const f32x4 e4 = *(const LAS f32x4*)(lds + GL_EBL + (32 * kt + 8 * g4 + 4 * hh) * 4);
#pragma unroll
                    for (int e = 0; e < 4; ++e) S[kt][4 * g4 + e] *= e4[e];
                }
#pragma unroll
                for (int ks = 0; ks < 4; ++ks) {
                    const bf16x8 a = *(const LAS bf16x8*)(lds + GL_KDT + (32 * kt + r) * 144 + ks * 32 + hh * 16);
                    S[kt] = MFMA32(a, bv[ks], S[kt]);
                }
            }
        }
        __syncthreads();
    }
}

constexpr int G2_SET = 43008, G2_QD = 0, G2_KDT = 8704, G2_VT = 18944, G2_SC = 39424, G2_EBL = 41984;
constexpr int G2_KI = 2 * G2_SET, G2_Z = G2_KI + 8704, G2_SEG = G2_Z + 16384;
#define G2_BAR() do { asm volatile("s_waitcnt lgkmcnt(0)" ::: "memory"); __builtin_amdgcn_s_barrier(); asm volatile("" ::: "memory"); } while (0)
__device__ __forceinline__ void gla_scan_phase2(LAS unsigned char* lds, const bf16_t* proj, const float* gbuf, const float* wgu  , const float* bg  ,
                                                bf16_t* ob0, bf16_t* ob1) {
    int tid = threadIdx.x; asm volatile("" : "+v"(tid));
    const int lane = tid & 63, wave = __builtin_amdgcn_readfirstlane(tid >> 6);
    const int r = lane & 31, hh = lane >> 5, fr = lane & 15, fq = lane >> 4;
    constexpr int CH = 32, NCH = SEQ / CH;
    for (int item = blockIdx.x; item < BATCH * 8; item += gridDim.x) {
        const int b = item >> 3, h = (item >> 1) & 3, dir = item & 1;
        if (wave < 4) {
            const int d = tid & 127, seg = (tid >> 7) & 1;
            const int zd = wave;
            bf16x8 wbh, wbl;
            {
                unsigned hi_[4], lo_[4];
#pragma unroll
                for (int q = 0; q < 4; ++q) {
                    const float w0 = wgu[(size_t)(dir * 16 + 8 * hh + 2 * q) * 512 + h * 128 + 32 * zd + r], w1 = wgu[(size_t)(dir * 16 + 8 * hh + 2 * q + 1) * 512 + h * 128 + 32 * zd + r];
                    hi_[q] = pk2(w0, w1); lo_[q] = pk2(w0 - bflo(hi_[q]), w1 - bfhi(hi_[q]));
                }
                wbh = __builtin_bit_cast(bf16x8, (u32x4){hi_[0], hi_[1], hi_[2], hi_[3]}); wbl = __builtin_bit_cast(bf16x8, (u32x4){lo_[0], lo_[1], lo_[2], lo_[3]});
            }
            const float zbias = bg[dir * 512 + h * 128 + 32 * zd + r];
            const __amdgpu_buffer_rsrc_t prs = __builtin_amdgcn_make_buffer_rsrc((void*)proj, 0, (unsigned)((size_t)MTOK * GINP * 2), 0x00020000);
            const unsigned qvoff = (unsigned)((16 * seg * GINP + h * 128 + d) * 2), vvoff = (unsigned)((16 * seg * GINP + 1024 + h * 256 + 2 * d) * 2);
            f32x4 gna, gnb;
            { const float* grow = gbuf + (size_t)(b * SEQ + (dir ? NCH - 1 : 0) * CH + r) * 32 + dir * 16 + 8 * hh; gna = *(const f32x4*)grow; gnb = *(const f32x4*)(grow + 4); }
            for (int n = 0; n <= NCH; ++n) {
                if (n < NCH) {
                    const int tok0 = b * SEQ + (dir ? NCH - 1 - n : n) * CH;
                    LAS unsigned char* set = lds + (n & 1) * G2_SET;
                    const f32x4 ga = gna, gb = gnb;
                    const unsigned srow = (unsigned)tok0 * (unsigned)(GINP * 2);
                    unsigned short qv[16], kv[16];
#pragma unroll
                    for (int ii = 0; ii < 16; ++ii) { qv[ii] = __builtin_amdgcn_raw_buffer_load_b16(prs, qvoff, srow + (unsigned)(ii * GINP * 2), 0);
                                                       kv[ii] = __builtin_amdgcn_raw_buffer_load_b16(prs, qvoff + 1024u, srow + (unsigned)(ii * GINP * 2), 0); }
                    unsigned vw[16];
#pragma unroll
                    for (int ii = 0; ii < 16; ++ii) vw[ii] = __builtin_amdgcn_raw_buffer_load_b32(prs, vvoff, srow + (unsigned)(ii * GINP * 2), 0);
                    { const int n1 = n + 1 < NCH ? n + 1 : n; const float* grow = gbuf + (size_t)(b * SEQ + (dir ? NCH - 1 - n1 : n1) * CH + r) * 32 + dir * 16 + 8 * hh;
                      gna = *(const f32x4*)grow; gnb = *(const f32x4*)(grow + 4); }
                    {
                        u32x4 ah, al;
                        ah.x = pk2(ga[0], ga[1]); ah.y = pk2(ga[2], ga[3]); ah.z = pk2(gb[0], gb[1]); ah.w = pk2(gb[2], gb[3]);
                        al.x = pk2(ga[0] - bflo(ah.x), ga[1] - bfhi(ah.x)); al.y = pk2(ga[2] - bflo(ah.y), ga[3] - bfhi(ah.y));
                        al.z = pk2(gb[0] - bflo(ah.z), gb[1] - bfhi(ah.z)); al.w = pk2(gb[2] - bflo(ah.w), gb[3] - bfhi(ah.w));
                        const bf16x8 gah = __builtin_bit_cast(bf16x8, ah), gal = __builtin_bit_cast(bf16x8, al);
                        f32x16 zacc;
#pragma unroll
                        for (int i = 0; i < 16; ++i) zacc[i] = zbias;
                        zacc = MFMA32(gah, wbh, zacc); zacc = MFMA32(gal, wbh, zacc); zacc = MFMA32(gah, wbl, zacc);
#pragma unroll
                        for (int i = 0; i < 16; ++i) *(LAS float*)(lds + G2_Z + (((i & 3) + 8 * (i >> 2) + 4 * hh) * 128 + 32 * zd + r) * 4) = zacc[i];
                    }
                    G2_BAR();
                    float cs[16];
#pragma unroll
                    for (int ii = 0; ii < 16; ++ii) {
                        const float z = *(const LAS float*)(lds + G2_Z + ((16 * seg + ii) * 128 + d) * 4);
                        cs[ii] = fminf(z, 0.f) * (1.4426950408889634f / 16.f) - __builtin_amdgcn_logf(1.f + __builtin_amdgcn_exp2f(fabsf(z) * -1.4426950408889634f)) * (1.f / 16.f);
                    }
                    if (dir == 0) {
#pragma unroll
                        for (int ii = 1; ii < 16; ++ii) cs[ii] += cs[ii - 1];
                        *(LAS float*)(lds + G2_SEG + (seg * 128 + d) * 4) = cs[15];
                    } else {
#pragma unroll
                        for (int ii = 14; ii >= 0; --ii) cs[ii] += cs[ii + 1];
                        *(LAS float*)(lds + G2_SEG + (seg * 128 + d) * 4) = cs[0];
                    }
                    G2_BAR();
                    {
                        const float t0 = *(const LAS float*)(lds + G2_SEG + d * 4), t1 = *(const LAS float*)(lds + G2_SEG + (128 + d) * 4);
                        const float prefix = dir == 0 ? (seg ? t0 : 0.f) : (seg ? 0.f : t1);
                        const float ebl = __builtin_amdgcn_exp2f(t0 + t1);
                        unsigned kd[8];
#pragma unroll
                        for (int ii = 0; ii < 16; ii += 2) {
                            const float e0 = __builtin_amdgcn_exp2f(prefix + cs[ii]), e1 = __builtin_amdgcn_exp2f(prefix + cs[ii + 1]);
                            const float q0 = bf2f(qv[ii]), q1 = bf2f(qv[ii + 1]);
                            const float k0 = bf2f(kv[ii]) * __builtin_amdgcn_rcpf(e0), k1 = bf2f(kv[ii + 1]) * __builtin_amdgcn_rcpf(e1);
                            const unsigned qd = pk2(q0 * e0, q1 * e1);
                            const unsigned ki = pk2(k0, k1);
                            kd[ii >> 1] = pk2(k0 * ebl, k1 * ebl);
                            const int i0 = 16 * seg + ii;
                            *(LAS unsigned short*)(set + G2_QD + i0 * 272 + d * 2) = (unsigned short)(qd & 0xffffu);
                            *(LAS unsigned short*)(set + G2_QD + (i0 + 1) * 272 + d * 2) = (unsigned short)(qd >> 16);
                            *(LAS unsigned short*)(lds + G2_KI + i0 * 272 + d * 2) = (unsigned short)(ki & 0xffffu);
                            *(LAS unsigned short*)(lds + G2_KI + (i0 + 1) * 272 + d * 2) = (unsigned short)(ki >> 16);
                        }
                        *(LAS u32x4*)(set + G2_KDT + d * 80 + seg * 32) = (u32x4){kd[0], kd[1], kd[2], kd[3]};
                        *(LAS u32x4*)(set + G2_KDT + d * 80 + seg * 32 + 16) = (u32x4){kd[4], kd[5], kd[6], kd[7]};
                        if (seg == 0) *(LAS float*)(set + G2_EBL + d * 4) = ebl;
                        unsigned c0[8], c1[8];
#pragma unroll
                        for (int t = 0; t < 8; ++t) { const unsigned a_ = vw[2 * t], b_ = vw[2 * t + 1]; c0[t] = (a_ & 0xffffu) | (b_ << 16); c1[t] = (a_ >> 16) | (b_ & 0xffff0000u); }
                        *(LAS u32x4*)(set + G2_VT + (2 * d) * 80 + seg * 32) = (u32x4){c0[0], c0[1], c0[2], c0[3]};
                        *(LAS u32x4*)(set + G2_VT + (2 * d) * 80 + seg * 32 + 16) = (u32x4){c0[4], c0[5], c0[6], c0[7]};
                        *(LAS u32x4*)(set + G2_VT + (2 * d + 1) * 80 + seg * 32) = (u32x4){c1[0], c1[1], c1[2], c1[3]};
                        *(LAS u32x4*)(set + G2_VT + (2 * d + 1) * 80 + seg * 32 + 16) = (u32x4){c1[4], c1[5], c1[6], c1[7]};
                    }
                    G2_BAR();
                    {
                        const int ti = wave >> 1, tj = wave & 1;
                        f32x4 a4 = (f32x4){0.f, 0.f, 0.f, 0.f};
#pragma unroll
                        for (int ks = 0; ks < 4; ++ks) {
                            const bf16x8 ka = *(const LAS bf16x8*)(lds + G2_KI + (16 * tj + fr) * 272 + ks * 64 + fq * 16);
                            const bf16x8 qb = *(const LAS bf16x8*)(set + G2_QD + (16 * ti + fr) * 272 + ks * 64 + fq * 16);
                            a4 = MFMA16(ka, qb, a4);
                        }
                        const int qi = 16 * ti + fr, kj = 16 * tj + 4 * fq;
                        float m[4];
#pragma unroll
                        for (int e = 0; e < 4; ++e) { const bool keep = dir ? (kj + e > qi) : (kj + e <= qi); m[e] = keep ? a4[e] : 0.f; }
                        u32x2 w; w.x = pk2(m[0], m[1]); w.y = pk2(m[2], m[3]);
                        *(LAS u32x2*)(set + G2_SC + qi * 80 + kj * 2) = w;
                    }
                    G2_BAR();
                } else { G2_BAR(); G2_BAR(); G2_BAR(); G2_BAR(); }
            }
        } else {
            const int cw = wave - 4;
            bf16_t* ob = dir ? ob1 : ob0;
            const __amdgpu_buffer_rsrc_t ors = __builtin_amdgcn_make_buffer_rsrc((void*)ob, 0, (unsigned)((size_t)MTOK * DM * 2), 0x00020000);
            const unsigned ovoff = (unsigned)((r * DM + h * 256 + 64 * cw + 4 * hh) * 2);
            f32x16 S[2][4];
#pragma unroll
            for (int nt2 = 0; nt2 < 2; ++nt2)
#pragma unroll
                for (int kt = 0; kt < 4; ++kt)
#pragma unroll
                    for (int i = 0; i < 16; ++i) S[nt2][kt][i] = 0.f;
            for (int n = 0; n <= NCH; ++n) {
                if (n >= 1) {
                    const int mch = n - 1;
                    const int tok0 = b * SEQ + (dir ? NCH - 1 - mch : mch) * CH;
                    const LAS unsigned char* set = lds + (mch & 1) * G2_SET;
                    bf16x8 bv[2][2];
#pragma unroll
                    for (int nt2 = 0; nt2 < 2; ++nt2)
#pragma unroll
                        for (int ks = 0; ks < 2; ++ks) bv[nt2][ks] = *(const LAS bf16x8*)(set + G2_VT + (64 * cw + 32 * nt2 + r) * 80 + ks * 32 + hh * 16);
                    f32x16 oacc[2];
#pragma unroll
                    for (int nt2 = 0; nt2 < 2; ++nt2)
#pragma unroll
                        for (int i = 0; i < 16; ++i) oacc[nt2][i] = 0.f;
#pragma unroll
                    for (int ks = 0; ks < 2; ++ks) {
                        const bf16x8 a = *(const LAS bf16x8*)(set + G2_SC + r * 80 + ks * 32 + hh * 16);
#pragma unroll
                        for (int nt2 = 0; nt2 < 2; ++nt2) oacc[nt2] = MFMA32(bv[nt2][ks], a, oacc[nt2]);
                    }
#define G2_OINTER(KT) do { _Pragma("unroll") for (int s = 0; s < 2; ++s) { __builtin_amdgcn_sched_barrier(0); \
                        const s16x4 lo = *(const LAS s16x4*)(set + G2_QD + r * 272 + (KT) * 64 + s * 32 + hh * 8); \
                        const s16x4 hi = *(const LAS s16x4*)(set + G2_QD + r * 272 + (KT) * 64 + s * 32 + hh * 8 + 16); \
                        const bf16x8 a = __builtin_shufflevector(lo, hi, 0, 1, 2, 3, 4, 5, 6, 7); \
                        _Pragma("unroll") for (int nt2 = 0; nt2 < 2; ++nt2) { u32x4 sp; \
                            sp.x = pk2(S[nt2][KT][8 * s + 0], S[nt2][KT][8 * s + 1]); sp.y = pk2(S[nt2][KT][8 * s + 2], S[nt2][KT][8 * s + 3]); \
                            sp.z = pk2(S[nt2][KT][8 * s + 4], S[nt2][KT][8 * s + 5]); sp.w = pk2(S[nt2][KT][8 * s + 6], S[nt2][KT][8 * s + 7]); \
                            oacc[nt2] = MFMA32(__builtin_bit_cast(bf16x8, sp), a, oacc[nt2]); } } } while (0)
                    G2_OINTER(0);
                    G2_BAR();
                    G2_OINTER(1); G2_OINTER(2);
                    G2_BAR();
                    G2_OINTER(3);
                    {
                        const unsigned orow = (unsigned)tok0 * (unsigned)(DM * 2);
#pragma unroll
                        for (int nt2 = 0; nt2 < 2; ++nt2)
#pragma unroll
                            for (int g = 0; g < 4; ++g) {
                                u32x2 w; w.x = pk2(oacc[nt2][4 * g], oacc[nt2][4 * g + 1]); w.y = pk2(oacc[nt2][4 * g + 2], oacc[nt2][4 * g + 3]);
                                __builtin_amdgcn_raw_buffer_store_b64(w, ors, ovoff + (unsigned)((32 * nt2 + 8 * g) * 2), orow, 0);
                            }
                    }
#define G2_STATE(KT) do { \
                        _Pragma("unroll") for (int g4 = 0; g4 < 4; ++g4) { const f32x4 e4 = *(const LAS f32x4*)(set + G2_EBL + (32 * (KT) + 8 * g4 + 4 * hh) * 4); \
                            _Pragma("unroll") for (int nt2 = 0; nt2 < 2; ++nt2) _Pragma("unroll") for (int e = 0; e < 4; ++e) S[nt2][KT][4 * g4 + e] *= e4[e]; } \
                        _Pragma("unroll") for (int ks = 0; ks < 2; ++ks) { const bf16x8 a = *(const LAS bf16x8*)(set + G2_KDT + (32 * (KT) + r) * 80 + ks * 32 + hh * 16); \
                            _Pragma("unroll") for (int nt2 = 0; nt2 < 2; ++nt2) S[nt2][KT] = MFMA32(a, bv[nt2][ks], S[nt2][KT]); } } while (0)
                    G2_STATE(0); G2_STATE(1);
                    G2_BAR();
                    G2_STATE(2); G2_STATE(3);
#undef G2_STATE
                    G2_BAR();
#undef G2_OINTER
                } else { G2_BAR(); G2_BAR(); G2_BAR(); G2_BAR(); }
            }
        }
        G2_BAR();
    }
}

__device__ __forceinline__ void gla_post_phase(const bf16_t* ob0, const bf16_t* ob1, const bf16_t* proj, const float* hgain, bf16_t* a2) {
    int tid = threadIdx.x; asm volatile("" : "+v"(tid));
    const int lane = tid & 63, wave = __builtin_amdgcn_readfirstlane(tid >> 6);
    const int gw = blockIdx.x * NWAVES + wave, NGW = gridDim.x * NWAVES;
    const int hp = lane >> 5, c8 = (lane & 31) * 8;
    const f32x4 hg0 = *(const f32x4*)(hgain + c8), hg1 = *(const f32x4*)(hgain + c8 + 4);
    u32x4 a[2], b[2], rr[2];
#define POST_LOAD(row_) do { _Pragma("unroll") for (int ps = 0; ps < 2; ++ps) { const size_t off_ = (size_t)(row_) * DM + (2 * ps + hp) * 256 + c8; \
        a[ps] = *(const u32x4*)(ob0 + off_); b[ps] = *(const u32x4*)(ob1 + off_); rr[ps] = *(const u32x4*)(proj + (size_t)(row_) * GINP + 2048 + (2 * ps + hp) * 256 + c8); } } while (0)
    if (gw < MTOK) POST_LOAD(gw);
    for (int row = gw; row < MTOK; row += NGW) {
        u32x4 ca[2], cb[2], cr[2];
#pragma unroll
        for (int ps = 0; ps < 2; ++ps) { ca[ps] = a[ps]; cb[ps] = b[ps]; cr[ps] = rr[ps]; }
        if (row + NGW < MTOK) POST_LOAD(row + NGW);
#pragma unroll
        for (int ps = 0; ps < 2; ++ps) {
            float o[8];
#pragma unroll
            for (int q = 0; q < 4; ++q) { o[2 * q] = bflo(ca[ps][q]) + bflo(cb[ps][q]); o[2 * q + 1] = bfhi(ca[ps][q]) + bfhi(cb[ps][q]); }
            float ss = 0.f;
#pragma unroll
            for (int q = 0; q < 8; ++q) ss += o[q] * o[q];
#pragma unroll
            for (int sh = 1; sh < 32; sh <<= 1) ss += __shfl_xor(ss, sh);
            const float rs = rsqrtf(ss * (1.f / 256.f) + EPS);
            u32x4 w;
            w.x = pk2(o[0] * rs * hg0[0] * silu_f(bflo(cr[ps].x)), o[1] * rs * hg0[1] * silu_f(bfhi(cr[ps].x)));
            w.y = pk2(o[2] * rs * hg0[2] * silu_f(bflo(cr[ps].y)), o[3] * rs * hg0[3] * silu_f(bfhi(cr[ps].y)));
            w.z = pk2(o[4] * rs * hg1[0] * silu_f(bflo(cr[ps].z)), o[5] * rs * hg1[1] * silu_f(bfhi(cr[ps].z)));
            w.w = pk2(o[6] * rs * hg1[2] * silu_f(bflo(cr[ps].w)), o[7] * rs * hg1[3] * silu_f(bfhi(cr[ps].w)));
            *(u32x4*)(a2 + (size_t)row * DM + (2 * ps + hp) * 256 + c8) = w;
        }
    }
#undef POST_LOAD
}

__device__ __forceinline__ void final_norm_phase(float* out, const bf16_t* xb, const float* ssq, const float* gain) {
    int tid = threadIdx.x; asm volatile("" : "+v"(tid));
    const int lane = tid & 63, wave = __builtin_amdgcn_readfirstlane(tid >> 6);
    const int gw = blockIdx.x * NWAVES + wave, NGW = gridDim.x * NWAVES;
    f32x4 g[4];
#pragma unroll
    for (int j = 0; j < 2; ++j) { g[2 * j] = *(const f32x4*)(gain + 512 * j + 8 * lane); g[2 * j + 1] = *(const f32x4*)(gain + 512 * j + 8 * lane + 4); }
    u32x4 w[2]; f32x4 sq;
#define FIN_LOAD(row_) do { w[0] = *(const u32x4*)(xb + (size_t)(row_) * DM + 8 * lane); w[1] = *(const u32x4*)(xb + (size_t)(row_) * DM + 512 + 8 * lane); sq = *(const f32x4*)(ssq + (size_t)(row_) * 4); } while (0)
    if (gw < MTOK) FIN_LOAD(gw);
    for (int row = gw; row < MTOK; row += NGW) {
        const u32x4 c0 = w[0], c1 = w[1]; const float rs = rsqrtf(((sq.x + sq.y) + (sq.z + sq.w)) * (1.f / 1024.f) + EPS);
        if (row + NGW < MTOK) FIN_LOAD(row + NGW);
        float* orow = out + (size_t)row * DM + 8 * lane;
        *(f32x4*)(orow) = (f32x4){bflo(c0.x), bfhi(c0.x), bflo(c0.y), bfhi(c0.y)} * rs * g[0];
        *(f32x4*)(orow + 4) = (f32x4){bflo(c0.z), bfhi(c0.z), bflo(c0.w), bfhi(c0.w)} * rs * g[1];
        *(f32x4*)(orow + 512) = (f32x4){bflo(c1.x), bfhi(c1.x), bflo(c1.y), bfhi(c1.y)} * rs * g[2];
        *(f32x4*)(orow + 516) = (f32x4){bflo(c1.z), bfhi(c1.z), bflo(c1.w), bfhi(c1.w)} * rs * g[3];
    }
#undef FIN_LOAD
}

#define XB_TMO      128
#define XB_XCNT(j)  (256  + 64 * (j))
#define XB_XSUB(j)  (1280 + 64 * (j))
#define XB_XGEN(j)  (2304 + 64 * (j))
#define XB_TOP      3328
#define XB_TOPGEN   3392
#define XCD_BAR_WORDS 3456
#define XB_SPIN_CAP (1u << 22)
__device__ __forceinline__ unsigned xb_ld(unsigned* p)              { return __hip_atomic_load(p, __ATOMIC_RELAXED, __HIP_MEMORY_SCOPE_AGENT); }
__device__ __forceinline__ unsigned xb_add(unsigned* p, unsigned v) { return __hip_atomic_fetch_add(p, v, __ATOMIC_RELAXED, __HIP_MEMORY_SCOPE_AGENT); }
__device__ __forceinline__ unsigned xb_xcc_id() { return (unsigned)__builtin_amdgcn_s_getreg((3 << 11) | 20) & 0xFu; }
#define XB_SPIN(cond, bar) do { unsigned _sp = 0; while (cond) { __builtin_amdgcn_s_sleep(1); \
    if ((++_sp & 255u) == 0u) { if (xb_ld(&(bar)[XB_TMO])) break; if (_sp > XB_SPIN_CAP) { atomicAdd(&(bar)[XB_TMO], 1u); break; } } } } while (0)
struct XcdBarrier { unsigned* bar; unsigned x; volatile LAS unsigned* st; };
__device__ __forceinline__ XcdBarrier xcd_barrier_post(unsigned* bar, volatile LAS unsigned* st) {
    XcdBarrier b; b.bar = bar; b.x = xb_xcc_id(); b.st = st;
    if (threadIdx.x == 0) (void)xb_add(&bar[XB_XCNT(b.x)], 1u);
    return b;
}
__device__ __forceinline__ void xcd_barrier_complete(unsigned* bar, unsigned x, unsigned& nloc, unsigned& nx) {
    const unsigned G = gridDim.x * gridDim.y * gridDim.z;
    unsigned sum, cnt, mine, sp = 0u;
    for (;;) {
        sum = 0u; cnt = 0u; mine = 0u;
#pragma unroll
        for (unsigned j = 0; j < 16; ++j) { const unsigned c = xb_ld(&bar[XB_XCNT(j)]); sum += c; cnt += (c > 0u) ? 1u : 0u; mine = (j == x) ? c : mine; }
        if (sum == G) break;
        __builtin_amdgcn_s_sleep(1);
        if ((++sp & 255u) == 0u) { if (xb_ld(&bar[XB_TMO])) break; if (sp > XB_SPIN_CAP) { atomicAdd(&bar[XB_TMO], 1u); break; } }
    }
    nloc = mine > 0u ? mine : 1u; nx = cnt > 0u ? cnt : 1u;
}
__device__ __forceinline__ void xcd_barrier(const XcdBarrier& b) {
    asm volatile("s_waitcnt vmcnt(0)" ::: "memory");
    __syncthreads();
    if (threadIdx.x == 0) {
        unsigned* bar = b.bar;
        __builtin_amdgcn_s_waitcnt(0);
        unsigned nloc = b.st[0], nx = b.st[1];
        if (nloc == 0u) { xcd_barrier_complete(bar, b.x, nloc, nx); b.st[0] = nloc; b.st[1] = nx; }
        const unsigned old = xb_add(&bar[XB_XSUB(b.x)], 1u);
        const unsigned gen = old / nloc;
        if (old + 1u == (gen + 1u) * nloc) {
            __builtin_amdgcn_fence(__ATOMIC_RELEASE, "agent");
            asm volatile("s_waitcnt vmcnt(0)" ::: "memory");
            const unsigned og = xb_add(&bar[XB_TOP], 1u);
            const unsigned tg = og / nx;
            if (og + 1u == (tg + 1u) * nx) xb_add(&bar[XB_TOPGEN], 1u);
            else XB_SPIN(xb_ld(&bar[XB_TOPGEN]) == tg, bar);
            __builtin_amdgcn_fence(__ATOMIC_ACQUIRE, "agent");
            xb_add(&bar[XB_XGEN(b.x)], 1u);
            asm volatile("s_waitcnt vmcnt(0)" ::: "memory");
        } else {
            XB_SPIN(xb_ld(&bar[XB_XGEN(b.x)]) == gen, bar);
            __builtin_amdgcn_fence(__ATOMIC_ACQUIRE, "agent");
            asm volatile("s_waitcnt vmcnt(0)" ::: "memory");
        }
    }
    __syncthreads();
}

__device__ __forceinline__ void rstd_cache_reset(LAS unsigned char* lds) {
    int tid = threadIdx.x; asm volatile("" : "+v"(tid));
    if (tid < 4) ((volatile LAS int*)(lds + pg8::STAGE_BYTES + 8208))[tid] = -1;
    __syncthreads();
}
__global__ void __launch_bounds__(NTHREADS, 2) fwd_megakernel(Params p) {
    extern __shared__ __attribute__((aligned(16))) unsigned char lds_raw[];
    LAS unsigned char* lds = (LAS unsigned char*)lds_raw;
    cg::grid_group grid = cg::this_grid();
    const int G = gridDim.x, bx = blockIdx.x;
    unsigned char* ws = p.ws;
    float* ssq = (float*)(ws + WS_SSQ);
    float* gbuf = (float*)(ws + WS_GBUF);
    bf16_t* XB = (bf16_t*)(ws + WS_XB);
    bf16_t* R2 = (bf16_t*)(ws + WS_R2);
    bf16_t* OB1 = (bf16_t*)(ws + WS_OB1);
    bf16_t* OB0 = (bf16_t*)p.out;
    bf16_t* R1 = (bf16_t*)(ws + WS_R1);
    if (threadIdx.x < 2) ((volatile LAS unsigned*)(lds + 139264))[threadIdx.x] = 0u;
    __syncthreads();
    const XcdBarrier xbar = xcd_barrier_post((unsigned*)ws, (volatile LAS unsigned*)(lds + 139264));
#define GRID_SYNC() xcd_barrier(xbar)

    p0_phase(p, lds);
    grid.sync();

#pragma unroll 1
    for (int layer = 0; layer < 4; ++layer) {
        const int j = layer >> 1;
        if ((layer & 1) == 0) {
            pool_prep_phase(lds, XB, ssq, p.norm_mix + layer * DM, R2);
            GRID_SYNC();
            { pg8::Gemm g{R2, (const bf16_t*)(ws + WS_WPOOL + j * SZ_WPOOL), 256, DM, 256, 256}; pg8::StaticOrder S; S.init(MTOK, DM, G, bx);
              pg8::EpiRes E{XB, XB, ssq};
              pg8::gemm_phase<pg8::EpiRes, pg8::StaticOrder>(lds, g, S, E); }
            GRID_SYNC();
        } else {
            { pg8::Gemm g{XB, (const bf16_t*)(ws + WS_WIN + j * SZ_WIN), DM, DM, DM, 0}; pg8::StaticOrder S; S.init(MTOK, GINP, G, bx);
              pg8::EpiProj E{R1, gbuf, ssq};
              pg8::gemm_phase<pg8::EpiProj, pg8::StaticOrder>(lds, g, S, E);
            }
            GRID_SYNC();
            gla_scan_phase2(lds, R1, gbuf, p.w_gate_up + (size_t)j * 2 * 16 * 512, p.b_gate + (size_t)j * 2 * 512, OB0, OB1);
            GRID_SYNC();
            gla_post_phase(OB0, OB1, R1, p.gla_head_norm + j * 256, R2);
            GRID_SYNC();
            { pg8::Gemm g{R2, (const bf16_t*)(ws + WS_WOUT + j * SZ_WOUT), DM, DM, DM, 0}; pg8::StaticOrder S; S.init(MTOK, DM, G, bx);
              pg8::EpiRes E{XB, XB, ssq};
              pg8::gemm_phase<pg8::EpiRes, pg8::StaticOrder>(lds, g, S, E); }
            GRID_SYNC();
        }
        { pg8::Gemm g{XB, (const bf16_t*)(ws + WS_WGU + layer * SZ_WGU), DM, DM, DM, 0}; pg8::StaticOrder S; S.init(MTOK, NGU, G, bx);
          pg8::EpiGU E{R1, ssq};
          pg8::gemm_phase<pg8::EpiGU, pg8::StaticOrder>(lds, g, S, E);
        }
        GRID_SYNC();
        { pg8::Gemm g{R1, (const bf16_t*)(ws + WS_WD + layer * SZ_WD), DFF, DFF, DFF, 0}; pg8::StaticOrder S; S.init(MTOK, DM, G, bx); S.rev = (S.nwg % G) == 0;
          pg8::EpiRes E{XB, XB, ssq};
          pg8::gemm_phase<pg8::EpiRes, pg8::StaticOrder>(lds, g, S, E); }
        GRID_SYNC();
    }
    final_norm_phase(p.out, XB, ssq, p.norm_final);
}

extern "C" void kernel_launch(void* const* d_in, const int* in_sizes, int n_in, void* d_out, int out_size, void* d_ws, size_t ws_size, hipStream_t stream) {
    static int grid = 0;
    if (grid == 0) {
        if (n_in != 14 || in_sizes[0] != MTOK * DM || out_size != MTOK * DM || ws_size < WS_END) {
            fprintf(stderr, "kernel_launch: unexpected shapes (n_in %d, in0 %d, out %d, ws %zu, need %zu); nothing launched\n", n_in, n_in > 0 ? in_sizes[0] : -1, out_size, ws_size, (size_t)WS_END);
            grid = -1; return;
        }
        int dev = 0, cus = 0, per_cu = 0;
        (void)hipGetDevice(&dev);
        (void)hipDeviceGetAttribute(&cus, hipDeviceAttributeMultiprocessorCount, dev);
        if (hipFuncSetAttribute((const void*)fwd_megakernel, hipFuncAttributeMaxDynamicSharedMemorySize, LDS_BYTES) != hipSuccess) { fprintf(stderr, "kernel_launch: hipFuncSetAttribute failed\n"); grid = -1; return; }
        if (hipOccupancyMaxActiveBlocksPerMultiprocessor(&per_cu, (const void*)fwd_megakernel, NTHREADS, LDS_BYTES) != hipSuccess || per_cu < 1) {
            fprintf(stderr, "kernel_launch: occupancy query says %d blocks per CU; using 1\n", per_cu); per_cu = 1; (void)hipGetLastError();
        }
        grid = cus * 1;
        fprintf(stderr, "kernel_launch: grid %d (cus %d, per_cu %d)\n", grid, cus, per_cu);
    }
    if (grid < 0) return;
    if (hipMemsetAsync(d_ws, 0, 16384, stream) != hipSuccess) { fprintf(stderr, "kernel_launch: memset failed\n"); return; }
    Params p{};
    p.x = (const float*)d_in[0]; p.norm_mix = (const float*)d_in[1]; p.norm_ffn = (const float*)d_in[2]; p.norm_final = (const float*)d_in[3];
    p.w_pool = (const float*)d_in[4]; p.pool_scale = (const float*)d_in[5]; p.w_gla_in = (const float*)d_in[6]; p.w_gate_up = (const float*)d_in[7];
    p.b_gate = (const float*)d_in[8]; p.gla_head_norm = (const float*)d_in[9]; p.w_gla_out = (const float*)d_in[10]; p.w_ffn_gate = (const float*)d_in[11];
    p.w_ffn_up = (const float*)d_in[12]; p.w_ffn_down = (const float*)d_in[13];
    p.out = (float*)d_out; p.ws = (unsigned char*)d_ws;
    void* args[] = {&p};
    hipError_t e = hipLaunchCooperativeKernel((const void*)fwd_megakernel, dim3(grid), dim3(NTHREADS), args, LDS_BYTES, stream);
    if (e != hipSuccess) fprintf(stderr, "kernel_launch: cooperative launch failed: %s (grid %d)\n", hipGetErrorString(e), grid);
}
```

```cpp
#include <hip/hip_runtime.h>
#include <hip/hip_cooperative_groups.h>
#include <cstdio>
#include <cstdint>
namespace cg = cooperative_groups;

#define LAS __attribute__((address_space(3)))
typedef unsigned short bf16_t;
typedef short bf16x8 __attribute__((ext_vector_type(8)));
typedef short s16x4 __attribute__((ext_vector_type(4)));
typedef float f32x4 __attribute__((ext_vector_type(4)));
typedef float f32x16 __attribute__((ext_vector_type(16)));
typedef float f32x2 __attribute__((ext_vector_type(2)));
typedef __bf16 bf16x2_t __attribute__((ext_vector_type(2)));
typedef unsigned u32x4 __attribute__((ext_vector_type(4)));
typedef unsigned u32x2 __attribute__((ext_vector_type(2)));

constexpr int DM = 1024, BATCH = 32, SEQ = 2048, MTOK = BATCH * SEQ, DFF = 2816, NGU = 2 * DFF, GIN = 3104, GINP = 3328;
constexpr int NWAVES = 8, NTHREADS = 512;
constexpr float EPS = 1e-6f;

constexpr size_t MiB = 1u << 20;
constexpr size_t SZ_WGU = (size_t)NGU * DM * 2, SZ_WD = (size_t)DM * DFF * 2, SZ_WIN = (size_t)GINP * DM * 2, SZ_WOUT = (size_t)DM * DM * 2, SZ_WPOOL = (size_t)DM * 256 * 2;
constexpr size_t WS_WGU = 1 * MiB, WS_WD = WS_WGU + 4 * SZ_WGU, WS_WIN = WS_WD + 4 * SZ_WD, WS_WOUT = WS_WIN + 2 * SZ_WIN, WS_WPOOL = WS_WOUT + 2 * SZ_WOUT, WS_WEND = WS_WPOOL + 2 * SZ_WPOOL;
static_assert(WS_WEND <= 100 * MiB, "weights");
constexpr size_t WS_SSQ = 100 * MiB;
constexpr size_t WS_GBUF = 104 * MiB;
constexpr size_t WS_XB = 112 * MiB;
constexpr size_t WS_R2 = 240 * MiB;
constexpr size_t WS_OB1 = 368 * MiB;
constexpr size_t WS_R1 = 496 * MiB;
constexpr size_t WS_END = 912 * MiB;

constexpr int LDS_BYTES = 147456;

__device__ __forceinline__ unsigned pk2(float lo, float hi) { f32x2 v = {lo, hi}; bf16x2_t b = __builtin_convertvector(v, bf16x2_t); return __builtin_bit_cast(unsigned, b); }
__device__ __forceinline__ float bf2f(unsigned u16) { return __uint_as_float(u16 << 16); }
__device__ __forceinline__ float bflo(unsigned w) { return __uint_as_float(w << 16); }
__device__ __forceinline__ float bfhi(unsigned w) { return __uint_as_float(w & 0xffff0000u); }
__device__ __forceinline__ float wave_sum(float v) {
#pragma unroll
    for (int o = 1; o < 64; o <<= 1) v += __shfl_xor(v, o);
    return v;
}
__device__ __forceinline__ float fexp(float x) { return __builtin_amdgcn_exp2f(x * 1.4426950408889634f); }
__device__ __forceinline__ float flog(float x) { return __builtin_amdgcn_logf(x) * 0.6931471805599453f; }
__device__ __forceinline__ float silu_f(float g) { return g * __builtin_amdgcn_rcpf(1.f + __builtin_amdgcn_exp2f(g * -1.4426950408889634f)); }
__device__ __forceinline__ float row_rstd(const float* ssq, int row) {
    const f32x4 a = *(const f32x4*)(ssq + (size_t)row * 4);
    const float s = (a.x + a.y) + (a.z + a.w);
    return rsqrtf(s * (1.f / 1024.f) + EPS);
}

namespace pg8 {
constexpr int BM = 256, BK = 64, HALF = 128, HTB = HALF * BK * 2, STAGE_BYTES = 8 * HTB, NXCD = 8, WGM = 4;
__host__ __device__ __forceinline__ int lds_byte(int r, int c) { const int st = (r >> 4) * 2 + (c >> 5), rr = r & 15, cc = c & 31, ob = rr * 64 + cc * 2; return st * 1024 + (ob ^ (((ob >> 9) & 1) << 5)); }
__host__ __device__ __forceinline__ void stage_rc(int b, int& R, int& C) { const int st = b / 1024, sb = b % 1024, swz = sb ^ (((sb >> 9) & 1) << 5); R = (st >> 1) * 16 + swz / 64; C = (st & 1) * 32 + (swz % 64) / 2; }
__host__ __device__ __forceinline__ int perm32(int rho) { const int n = rho >> 4, i = rho & 15; return 8 * (i >> 2) + 4 * n + (i & 3); }

struct Unit { int pm, pn; };
struct Gemm { const bf16_t* A; const bf16_t* Bt; int K, lda, ldb, a_pn_off; };

struct StaticOrder {
    int nM, nN, nwg, G, c; bool rev = false;
    __host__ __device__ void init(int M, int N, int G_, int c_) { nM = M / BM; nN = N / BM; nwg = nM * nN; G = G_; c = c_; }
    __host__ __device__ bool next(int i, Unit& u) const {
        const int nr = (nwg + G - 1) / G; if (i >= nr) return false;
        const long L = (long)(rev ? nr - 1 - i : i) * G + c; if (L >= nwg) return false;
        int wgid = (int)L; { const int q = nwg / NXCD, r = nwg % NXCD, xcd = wgid % NXCD, off = wgid / NXCD; wgid = (xcd < r ? xcd * (q + 1) : r * (q + 1) + (xcd - r) * q) + off; }
        const int nig = WGM * nN, gid = wgid / nig, fm = gid * WGM, gsz = (nM - fm) < WGM ? (nM - fm) : WGM;
        u.pm = fm + ((wgid % nig) % gsz); u.pn = (wgid % nig) / gsz; return true;
    }
};


__device__ __forceinline__ const LAS float* rstd_panel(LAS unsigned char* lds, const float* ssq, int pm, int tid) {
    LAS float* RT = (LAS float*)(lds + STAGE_BYTES + 4096); volatile LAS int* TG = (volatile LAS int*)(lds + STAGE_BYTES + 8208);
    const int slot = (pm >> 3) & 3;
    asm volatile("s_waitcnt lgkmcnt(0)" ::: "memory"); __builtin_amdgcn_s_barrier(); asm volatile("" ::: "memory");
    if (TG[slot] != pm) {
        if (tid < 256) RT[slot * 256 + tid] = row_rstd(ssq, pm * BM + tid);
        asm volatile("s_waitcnt lgkmcnt(0)" ::: "memory"); __builtin_amdgcn_s_barrier(); asm volatile("" ::: "memory");
        if (tid == 0) TG[slot] = pm;
    }
    return RT + slot * 256;
}
struct EpiGU {
    static constexpr bool PERM = true;
    bf16_t* H; const float* ssq;
    __device__ __forceinline__ void operator()(const f32x4 (&acc)[2][2][4][2], const Unit& u, int wr, int wc, int fr, int fq, LAS unsigned char* lds, int tid) const {
        const int row0 = u.pm * BM + wr * 64 + fr, col0 = u.pn * 128 + wc * 32 + 8 * fq;
        const LAS float* RT = rstd_panel(lds, ssq, u.pm, tid);
#pragma unroll
        for (int ai = 0; ai < 2; ++ai) {
            float rs[4];
#pragma unroll
            for (int m = 0; m < 4; ++m) rs[m] = RT[wr * 64 + fr + ai * HALF + m * 16];
#pragma unroll
            for (int m = 0; m < 4; ++m) {
                const int row = row0 + ai * HALF + m * 16; const float r = rs[m];
                const f32x4 g0 = acc[ai][0][m][0] * r, g1 = acc[ai][0][m][1] * r, u0 = acc[ai][1][m][0] * r, u1 = acc[ai][1][m][1] * r;
                u32x4 w;
                w.x = pk2(silu_f(g0[0]) * u0[0], silu_f(g0[1]) * u0[1]); w.y = pk2(silu_f(g0[2]) * u0[2], silu_f(g0[3]) * u0[3]);
                w.z = pk2(silu_f(g1[0]) * u1[0], silu_f(g1[1]) * u1[1]); w.w = pk2(silu_f(g1[2]) * u1[2], silu_f(g1[3]) * u1[3]);
                *(u32x4*)(H + (size_t)row * DFF + col0) = w;
            }
        }
    }
};
struct EpiProj {
    static constexpr bool PERM = true;
    bf16_t* P; float* gbuf; const float* ssq;
    __device__ __forceinline__ void operator()(const f32x4 (&acc)[2][2][4][2], const Unit& u, int wr, int wc, int fr, int fq, LAS unsigned char* lds, int tid) const {
        const int row0 = u.pm * BM + wr * 64 + fr, col0 = u.pn * BM + wc * 32 + 8 * fq;
        const bool gate = (u.pn == 12) && (wc == 0);
        const LAS float* RT = rstd_panel(lds, ssq, u.pm, tid);
#pragma unroll
        for (int ai = 0; ai < 2; ++ai) {
            float rs[4];
#pragma unroll
            for (int m = 0; m < 4; ++m) rs[m] = RT[wr * 64 + fr + ai * HALF + m * 16];
#pragma unroll
            for (int m = 0; m < 4; ++m) {
                const int row = row0 + ai * HALF + m * 16; const float r = rs[m];
#pragma unroll
                for (int bj = 0; bj < 2; ++bj) {
                    const f32x4 v0 = acc[ai][bj][m][0] * r, v1 = acc[ai][bj][m][1] * r;
                    u32x4 w; w.x = pk2(v0[0], v0[1]); w.y = pk2(v0[2], v0[3]); w.z = pk2(v1[0], v1[1]); w.w = pk2(v1[2], v1[3]);
                    *(u32x4*)(P + (size_t)row * GINP + col0 + bj * HALF) = w;
                    if (bj == 0 && gate) { float* gp = gbuf + (size_t)row * 32 + 8 * fq; *(f32x4*)gp = v0; *(f32x4*)(gp + 4) = v1; }
                }
            }
        }
    }
};
struct EpiRes {
    static constexpr bool PERM = true;
    const bf16_t* xin; bf16_t* xb; float* ssq;
    __device__ __forceinline__ void operator()(const f32x4 (&acc)[2][2][4][2], const Unit& u, int wr, int wc, int fr, int fq, LAS unsigned char* lds, int tid) const {
        const int col0 = u.pn * BM + wc * 32 + 8 * fq;
        LAS float* RED = (LAS float*)(lds + STAGE_BYTES);
#pragma unroll
        for (int ai = 0; ai < 2; ++ai) {
            u32x4 bw[4][2];
#pragma unroll
            for (int m = 0; m < 4; ++m)
#pragma unroll
                for (int bj = 0; bj < 2; ++bj) bw[m][bj] = *(const u32x4*)(xin + (size_t)(u.pm * BM + ai * HALF + wr * 64 + m * 16 + fr) * DM + col0 + bj * HALF);
#pragma unroll
            for (int m = 0; m < 4; ++m) {
                const int rl = ai * HALF + wr * 64 + m * 16 + fr;
                bf16_t* xp = xb + (size_t)(u.pm * BM + rl) * DM + col0;
                float sq = 0.f;
#pragma unroll
                for (int bj = 0; bj < 2; ++bj) {
                    const u32x4 w0 = bw[m][bj];
                    const f32x4 o0 = (f32x4){bflo(w0.x), bfhi(w0.x), bflo(w0.y), bfhi(w0.y)} + acc[ai][bj][m][0];
                    const f32x4 o1 = (f32x4){bflo(w0.z), bfhi(w0.z), bflo(w0.w), bfhi(w0.w)} + acc[ai][bj][m][1];
                    sq += ((o0[0] * o0[0] + o0[1] * o0[1]) + (o0[2] * o0[2] + o0[3] * o0[3])) + ((o1[0] * o1[0] + o1[1] * o1[1]) + (o1[2] * o1[2] + o1[3] * o1[3]));
                    u32x4 w; w.x = pk2(o0[0], o0[1]); w.y = pk2(o0[2], o0[3]); w.z = pk2(o1[0], o1[1]); w.w = pk2(o1[2], o1[3]);
                    *(u32x4*)(xp + bj * HALF) = w;
                }
                sq += __shfl_xor(sq, 16); sq += __shfl_xor(sq, 32);
                if (fq == 0) RED[wc * 256 + rl] = sq;
            }
        }
        asm volatile("s_waitcnt lgkmcnt(0)" ::: "memory"); __builtin_amdgcn_s_barrier(); asm volatile("" ::: "memory");
        if (tid < 256) ssq[(size_t)(u.pm * BM + tid) * 4 + u.pn] = (RED[tid] + RED[256 + tid]) + (RED[512 + tid] + RED[768 + tid]);
    }
};

template <class Epi, class Sched>
__device__ __forceinline__ void gemm_phase(LAS unsigned char* lds, const Gemm g, const Sched& S, const Epi& E) {
    int tid = threadIdx.x; asm volatile("" : "+v"(tid));
    const int wid = __builtin_amdgcn_readfirstlane(tid >> 6), lane = tid & 63, wr = wid >> 2, wc = wid & 3, fr = lane & 15, fq = lane >> 4;
    const int K = g.K, nt = K / BK;
    unsigned voffA[2], voffB[2];
#pragma unroll
    for (int i = 0; i < 2; ++i) { int R, C; stage_rc(tid * 16 + i * 8192, R, C); const int Rb = Epi::PERM ? ((R & ~31) + perm32(R & 31)) : R;
        voffA[i] = (unsigned)(R * g.lda + C) * 2u; voffB[i] = (unsigned)(Rb * g.ldb + C) * 2u; }
    const size_t kstep = (size_t)(BK * 2);
    const size_t hstepA = (size_t)HALF * g.lda * 2, hstepB = (size_t)HALF * g.ldb * 2;
    const size_t tstepA = 2 * hstepA, tstepB = 2 * hstepB, apn = (size_t)g.a_pn_off * 2;
    const unsigned ldsw = (unsigned)wid * 1024u;
    const int aoff = lds_byte(wr * 64 + fr, fq * 8), boff = lds_byte(wc * 32 + fr, fq * 8);
#define PG8_SA(b, h) (((b) * 2 + (h)) * HTB)
#define PG8_SB(b, h) ((4 + (b) * 2 + (h)) * HTB)
#define PG8_STAGE(bufoff, gbase, voff) do { _Pragma("unroll") for (int _i = 0; _i < 2; ++_i) \
        __builtin_amdgcn_global_load_lds((const unsigned*)((const char*)(gbase) + (voff)[_i]), (LAS unsigned*)(lds + (bufoff) + ldsw + _i * 8192), 16, 0, 0); } while (0)
#define PG8_LDA(dst, b, h) do { _Pragma("unroll") for (int m = 0; m < 4; ++m) _Pragma("unroll") for (int k = 0; k < 2; ++k) dst[m][k] = *(const LAS bf16x8*)(lds + PG8_SA(b, h) + aoff + m * 2048 + k * 1024); } while (0)
#define PG8_LDB(dst, b, h) do { _Pragma("unroll") for (int n = 0; n < 2; ++n) _Pragma("unroll") for (int k = 0; k < 2; ++k) dst[n][k] = *(const LAS bf16x8*)(lds + PG8_SB(b, h) + boff + n * 2048 + k * 1024); } while (0)
#define PG8_MMA(ai, bj, At, Bt) do { __builtin_amdgcn_s_setprio(1); _Pragma("unroll") for (int m = 0; m < 4; ++m) _Pragma("unroll") for (int n = 0; n < 2; ++n) _Pragma("unroll") for (int k = 0; k < 2; ++k) \
        acc[ai][bj][m][n] = __builtin_amdgcn_mfma_f32_16x16x32_bf16(Bt[n][k], At[m][k], acc[ai][bj][m][n], 0, 0, 0); __builtin_amdgcn_s_setprio(0); } while (0)
#define PG8_WAIT_V(n) asm volatile("s_waitcnt vmcnt(" #n ")" ::: "memory")
#define PG8_WAIT_L(n) asm volatile("s_waitcnt lgkmcnt(" #n ")" ::: "memory")
#define PG8_BAR __builtin_amdgcn_s_barrier()
#define PG8_SCHED __builtin_amdgcn_sched_barrier(0)
    Unit cur, nxt; int ui = 0;
    if (!S.next(0, cur)) return;
    f32x4 acc[2][2][4][2];
#pragma unroll
    for (int a = 0; a < 2; ++a)
#pragma unroll
        for (int b = 0; b < 2; ++b)
#pragma unroll
            for (int m = 0; m < 4; ++m)
#pragma unroll
                for (int n = 0; n < 2; ++n) acc[a][b][m][n] = (f32x4){0.f, 0.f, 0.f, 0.f};
    bf16x8 At[4][2], B0[2][2], B1[2][2];
    const char* cA = (const char*)g.A + (size_t)cur.pm * tstepA + (size_t)cur.pn * apn; const char* cB = (const char*)g.Bt + (size_t)cur.pn * tstepB;
    PG8_STAGE(PG8_SB(0, 0), cB, voffB); PG8_STAGE(PG8_SB(0, 1), cB + hstepB, voffB); PG8_STAGE(PG8_SA(0, 0), cA, voffA); PG8_STAGE(PG8_SA(0, 1), cA + hstepA, voffA);
    if (wr == 1) PG8_BAR;
    PG8_WAIT_V(2); PG8_BAR;
    PG8_STAGE(PG8_SB(1, 0), cB + kstep, voffB); PG8_STAGE(PG8_SA(1, 0), cA + kstep, voffA); PG8_STAGE(PG8_SB(1, 1), cB + hstepB + kstep, voffB);
    PG8_WAIT_V(6); PG8_BAR;
    for (;;) {
        const bool has_next = S.next(ui + 1, nxt);
        const char* nA = has_next ? (const char*)g.A + (size_t)nxt.pm * tstepA + (size_t)nxt.pn * apn : cA; const char* nB = has_next ? (const char*)g.Bt + (size_t)nxt.pn * tstepB : cB;
        for (int t = 0; t < nt; t += 2) {
            const bool last = (t == nt - 2);
            const char* a1 = cA + (size_t)(t + 1) * kstep;
            const char* a2 = last ? nA : cA + (size_t)(t + 2) * kstep; const char* b2 = last ? nB : cB + (size_t)(t + 2) * kstep;
            const char* a3 = a2 + kstep; const char* b3 = b2 + kstep;
            PG8_LDB(B0, 0, 0); PG8_LDB(B1, 0, 1); PG8_SCHED; PG8_LDA(At, 0, 0); PG8_STAGE(PG8_SA(1, 1), a1 + hstepA, voffA);
            PG8_WAIT_V(8); PG8_WAIT_L(0); PG8_BAR; PG8_MMA(0, 0, At, B0); PG8_MMA(0, 1, At, B1); PG8_BAR; PG8_SCHED;
            PG8_LDA(At, 0, 1); PG8_STAGE(PG8_SB(0, 0), b2, voffB); PG8_STAGE(PG8_SB(0, 1), b2 + hstepB, voffB); PG8_STAGE(PG8_SA(0, 0), a2, voffA);
            PG8_WAIT_V(8); PG8_WAIT_L(0); PG8_BAR; PG8_MMA(1, 0, At, B0); PG8_MMA(1, 1, At, B1); PG8_BAR; PG8_SCHED;
            PG8_LDB(B0, 1, 0); PG8_LDB(B1, 1, 1); PG8_SCHED; PG8_LDA(At, 1, 0); PG8_STAGE(PG8_SA(0, 1), a2 + hstepA, voffA);
            PG8_WAIT_V(8); PG8_WAIT_L(0); PG8_BAR; PG8_MMA(0, 0, At, B0); PG8_MMA(0, 1, At, B1); PG8_BAR; PG8_SCHED;
            PG8_LDA(At, 1, 1); PG8_STAGE(PG8_SB(1, 0), b3, voffB); PG8_STAGE(PG8_SB(1, 1), b3 + hstepB, voffB); PG8_STAGE(PG8_SA(1, 0), a3, voffA);
            PG8_WAIT_V(8); PG8_WAIT_L(0); PG8_BAR; PG8_MMA(1, 0, At, B0); PG8_MMA(1, 1, At, B1); PG8_BAR; PG8_SCHED;
        }
        if (wr == 0) PG8_BAR;
        E(acc, cur, wr, wc, fr, fq, lds, tid);
        if (!has_next) break;
#pragma unroll
        for (int a = 0; a < 2; ++a)
#pragma unroll
            for (int b = 0; b < 2; ++b)
#pragma unroll
                for (int m = 0; m < 4; ++m)
#pragma unroll
                    for (int n = 0; n < 2; ++n) acc[a][b][m][n] = (f32x4){0.f, 0.f, 0.f, 0.f};
        cur = nxt; cA = nA; cB = nB; ++ui;
        if (wr == 1) PG8_BAR;
    }
    PG8_WAIT_V(0);
    PG8_BAR;
#undef PG8_SA
#undef PG8_SB
#undef PG8_STAGE
#undef PG8_LDA
#undef PG8_LDB
#undef PG8_MMA
#undef PG8_WAIT_V
#undef PG8_WAIT_L
#undef PG8_BAR
#undef PG8_SCHED
}
}

struct Params {
    const float* x; const float* norm_mix; const float* norm_ffn; const float* norm_final;
    const float* w_pool; const float* pool_scale; const float* w_gla_in; const float* w_gate_up; const float* b_gate;
    const float* gla_head_norm; const float* w_gla_out; const float* w_ffn_gate; const float* w_ffn_up; const float* w_ffn_down;
    float* out; unsigned char* ws;
};

struct P0Item { const float* W; bf16_t* WT; const float* kscale; const float* nscale; int N, ldt, k0, n0, drow0; float cscale; };
__device__ __forceinline__ P0Item p0_decode(const Params& p, int it) {
    constexpr int I_G = (DM / 64) * (DFF / 32), I_D = (DFF / 64) * (DM / 32), I_L = 2 * I_G + I_D;
    constexpr int I_IN = (DM / 64) * (GIN / 32), I_OUT = (DM / 64) * (DM / 32), I_J = I_IN + I_OUT;
    constexpr int I_P = (256 / 64) * (256 / 32);
    unsigned char* ws = p.ws; P0Item q; int r = it;
    if (r < 4 * I_L) {
        const int l = r / I_L; r -= l * I_L;
        if (r < 2 * I_G) {
            const int up = r / I_G; r -= up * I_G;
            const int nb = r % (DFF / 32), kb = r / (DFF / 32), n0 = nb * 32;
            q.W = (up ? p.w_ffn_up : p.w_ffn_gate) + (size_t)l * DM * DFF; q.N = DFF; q.WT = (bf16_t*)(ws + WS_WGU + l * SZ_WGU); q.ldt = DM; q.k0 = kb * 64; q.n0 = n0;
            q.drow0 = (n0 >> 7) * 256 + up * 128 + (n0 & 127); q.kscale = p.norm_ffn + l * DM; q.nscale = nullptr; q.cscale = 1.f;
        } else {
            r -= 2 * I_G;
            const int nb = r % (DM / 32), kb = r / (DM / 32), n0 = nb * 32;
            q.W = p.w_ffn_down + (size_t)l * DFF * DM; q.N = DM; q.WT = (bf16_t*)(ws + WS_WD + l * SZ_WD); q.ldt = DFF; q.k0 = kb * 64; q.n0 = n0; q.drow0 = n0; q.kscale = nullptr; q.nscale = nullptr; q.cscale = 1.f;
        }
        return q;
    }
    r -= 4 * I_L;
    if (r < 2 * I_J) {
        const int j = r / I_J; r -= j * I_J;
        if (r < I_IN) {
            const int nb = r % (GIN / 32), kb = r / (GIN / 32), n0 = nb * 32;
            q.W = p.w_gla_in + (size_t)j * DM * GIN; q.N = GIN; q.WT = (bf16_t*)(ws + WS_WIN + j * SZ_WIN); q.ldt = DM; q.k0 = kb * 64; q.n0 = n0; q.drow0 = n0;
            q.kscale = p.norm_mix + (2 * j + 1) * DM; q.nscale = nullptr; q.cscale = n0 < 512 ? 0.08838834764831845f : 1.f;
        } else {
            r -= I_IN;
            const int nb = r % (DM / 32), kb = r / (DM / 32), n0 = nb * 32;
            q.W = p.w_gla_out + (size_t)j * DM * DM; q.N = DM; q.WT = (bf16_t*)(ws + WS_WOUT + j * SZ_WOUT); q.ldt = DM; q.k0 = kb * 64; q.n0 = n0; q.drow0 = n0; q.kscale = nullptr; q.nscale = nullptr; q.cscale = 1.f;
        }
        return q;
    }
    r -= 2 * I_J;
    {
        const int jg = r / I_P; r -= jg * I_P; const int j = jg >> 2, g = jg & 3;
        const int nb = r % 8, kb = r / 8, n0 = nb * 32;
        q.W = p.w_pool + (size_t)jg * 256 * 256; q.N = 256; q.WT = (bf16_t*)(ws + WS_WPOOL + j * SZ_WPOOL); q.ldt = 256; q.k0 = kb * 64; q.n0 = n0; q.drow0 = g * 256 + n0;
        q.kscale = nullptr; q.nscale = p.pool_scale + j * DM + g * 256; q.cscale = 1.f;
    }
    return q;
}
__device__ __forceinline__ void p0_load(const P0Item& q, int lane, float (&v)[32]) {
#pragma unroll
    for (int i = 0; i < 32; ++i) { const int kk = 2 * i + (lane >> 5); v[i] = q.W[(size_t)(q.k0 + kk) * q.N + q.n0 + (lane & 31)]; }
}
__device__ __forceinline__ void p0_finish(const P0Item& q, LAS float* scr, int lane, const float (&v)[32]) {
#pragma unroll
    for (int i = 0; i < 32; ++i) { const int kk = 2 * i + (lane >> 5); scr[kk * 33 + (lane & 31)] = v[i]; }
    asm volatile("s_waitcnt lgkmcnt(0)" ::: "memory");
    const int c = lane & 7;
    f32x4 ka = (f32x4){1.f, 1.f, 1.f, 1.f}, kb = ka;
    if (q.kscale) { ka = *(const f32x4*)(q.kscale + q.k0 + 8 * c); kb = *(const f32x4*)(q.kscale + q.k0 + 8 * c + 4); }
#pragma unroll
    for (int j = 0; j < 4; ++j) { const int n = (lane >> 3) + 8 * j; const LAS float* s = scr + (8 * c) * 33 + n;
        const float ns = (q.nscale ? q.nscale[q.n0 + n] : 1.f) * q.cscale;
        u32x4 o; o.x = pk2(s[0 * 33] * ka[0] * ns, s[1 * 33] * ka[1] * ns); o.y = pk2(s[2 * 33] * ka[2] * ns, s[3 * 33] * ka[3] * ns);
        o.z = pk2(s[4 * 33] * kb[0] * ns, s[5 * 33] * kb[1] * ns); o.w = pk2(s[6 * 33] * kb[2] * ns, s[7 * 33] * kb[3] * ns);
        *(u32x4*)(q.WT + (size_t)(q.drow0 + n) * q.ldt + q.k0 + 8 * c) = o; }
    asm volatile("s_waitcnt lgkmcnt(0)" ::: "memory");
}

__device__ __forceinline__ void p0_phase(const Params& p, LAS unsigned char* lds) {
    int tid = threadIdx.x; asm volatile("" : "+v"(tid));
    const int lane = tid & 63, wave = __builtin_amdgcn_readfirstlane(tid >> 6);
    LAS float* scr = (LAS float*)(lds + wave * 16384);
    const int gw = blockIdx.x * NWAVES + wave, NGW = gridDim.x * NWAVES;
    constexpr int NITEMS = 4 * (2 * (DM / 64) * (DFF / 32) + (DFF / 64) * (DM / 32)) + 2 * ((DM / 64) * (GIN / 32) + (DM / 64) * (DM / 32)) + 8 * (256 / 64) * (256 / 32);
    unsigned char* ws = p.ws;
    if (gw < NITEMS) {
        P0Item cur = p0_decode(p, gw); float v[32]; p0_load(cur, lane, v);
        for (int it = gw; it < NITEMS; it += NGW) {
            const int nit = it + NGW < NITEMS ? it + NGW : it;
            const P0Item nxt = p0_decode(p, nit); float vn[32]; p0_load(nxt, lane, vn);
            p0_finish(cur, scr, lane, v);
            cur = nxt;
#pragma unroll
            for (int i = 0; i < 32; ++i) v[i] = vn[i];
        }
    }
    for (int e = gw * 64 + lane; e < 2 * (GINP - GIN) * DM / 8; e += NGW * 64) {
        const int j = e / ((GINP - GIN) * DM / 8), q = e % ((GINP - GIN) * DM / 8);
        *(u32x4*)(ws + WS_WIN + j * SZ_WIN + (size_t)GIN * DM * 2 + (size_t)q * 16) = (u32x4){0u, 0u, 0u, 0u};
    }
    float* ssq = (float*)(ws + WS_SSQ);
    {
        f32x4 v[4];
#define P0_LOAD(row_) do { const f32x4* xr_ = (const f32x4*)(p.x + (size_t)(row_) * DM) + lane; _Pragma("unroll") for (int j = 0; j < 4; ++j) v[j] = xr_[64 * j]; } while (0)
        if (gw < MTOK) P0_LOAD(gw);
        for (int row = gw; row < MTOK; row += NGW) {
            f32x4 c[4];
#pragma unroll
            for (int j = 0; j < 4; ++j) c[j] = v[j];
            if (row + NGW < MTOK) P0_LOAD(row + NGW);
            float s = 0.f;
            u32x2* xo = (u32x2*)(ws + WS_XB + (size_t)row * DM * 2) + lane;
#pragma unroll
            for (int j = 0; j < 4; ++j) { s += (c[j].x * c[j].x + c[j].y * c[j].y) + (c[j].z * c[j].z + c[j].w * c[j].w); u32x2 w; w.x = pk2(c[j].x, c[j].y); w.y = pk2(c[j].z, c[j].w); xo[64 * j] = w; }
            s = wave_sum(s);
            if (lane < 4) ssq[(size_t)row * 4 + lane] = lane == 0 ? s : 0.f;
        }
#undef P0_LOAD
    }
}

__device__ __forceinline__ void pool_prep_phase(LAS unsigned char* lds, const bf16_t* x, const float* ssq, const float* gain, bf16_t* mixed) {
    int tid = threadIdx.x; asm volatile("" : "+v"(tid));
    LAS float* HT = (LAS float*)lds; LAS float* RS = (LAS float*)(lds + 81920);
    const int nitems = MTOK / 64;
    const int nit = (int)blockIdx.x < nitems ? (nitems - (int)blockIdx.x + (int)gridDim.x - 1) / (int)gridDim.x : 0;
    const int nsteps = nit * 4;
    u32x2 raw[10];
#define PP_GEO(st_) const int g_ = (st_) & 3, tok0_ = ((int)blockIdx.x + ((st_) >> 2) * (int)gridDim.x) * 64, s0_ = tok0_ & (SEQ - 1); \
        const int win_ = 2 << g_, left_ = win_ >> 1, right_ = win_ - 1 - left_, rlo_ = 8 - left_, nrows_ = 64 + left_ + right_;
#define PP_LOAD(st_) do { PP_GEO(st_) _Pragma("unroll") for (int k = 0; k < 10; ++k) { const int e = tid + k * NTHREADS; raw[k] = (u32x2){0u, 0u}; \
        if (e < nrows_ * 64) { const int rr = rlo_ + (e >> 6), c4 = e & 63, pos = s0_ - 8 + rr; \
            if (pos >= 0 && pos < SEQ) raw[k] = *(const u32x2*)(x + (size_t)(tok0_ - 8 + rr) * DM + g_ * 256 + c4 * 4); } } } while (0)
    if (nsteps > 0) PP_LOAD(0);
    for (int st = 0; st < nsteps; ++st) {
        PP_GEO(st)
        if (g_ == 0) {
            if (tid < 79) { const int pos = s0_ - 8 + tid; float r = 0.f; if (pos >= 0 && pos < SEQ) r = row_rstd(ssq, tok0_ - 8 + tid); RS[tid] = r; }
            __syncthreads();
        }
#pragma unroll
        for (int k = 0; k < 10; ++k) {
            const int e = tid + k * NTHREADS;
            if (e < nrows_ * 64) { const int rr = rlo_ + (e >> 6), c4 = e & 63; const u32x2 w = raw[k];
                *(LAS f32x4*)(HT + rr * 256 + c4 * 4) = (f32x4){bflo(w.x), bfhi(w.x), bflo(w.y), bfhi(w.y)} * RS[rr]; }
        }
        __syncthreads();
        if (st + 1 < nsteps) PP_LOAD(st + 1);
        {
            const int cq = tid & 63, tq = tid >> 6;
            const f32x4 gn = *(const f32x4*)(gain + g_ * 256 + cq * 4);
            const int tl0 = tq * 8;
            f32x4 sum = (f32x4){0.f, 0.f, 0.f, 0.f};
            for (int q = -left_; q <= right_; ++q) sum += *(const LAS f32x4*)(HT + (tl0 + 8 + q) * 256 + cq * 4);
#pragma unroll
            for (int tt = 0; tt < 8; ++tt) {
                const int tl = tl0 + tt, pos = s0_ + tl;
                const int lo = (pos - left_) > 0 ? (pos - left_) : 0, hi = (pos + right_ + 1) < SEQ ? (pos + right_ + 1) : SEQ;
                const f32x4 self = *(const LAS f32x4*)(HT + (tl + 8) * 256 + cq * 4);
                const f32x4 o = (sum * __builtin_amdgcn_rcpf((float)(hi - lo)) - self) * gn;
                u32x2 w; w.x = pk2(o[0], o[1]); w.y = pk2(o[2], o[3]);
                *(u32x2*)(mixed + (size_t)(tok0_ + tl) * DM + g_ * 256 + cq * 4) = w;
                if (tt < 7) { sum += *(const LAS f32x4*)(HT + (tl + 8 + right_ + 1) * 256 + cq * 4); sum -= *(const LAS f32x4*)(HT + (tl + 8 - left_) * 256 + cq * 4); }
            }
        }
        __syncthreads();
    }
#undef PP_LOAD
#undef PP_GEO
}

constexpr int GL_QD = 0, GL_KI = 17408, GL_KDT = 34816, GL_VT = 53248, GL_SC = 90112, GL_Z = 99328  , GL_SEG = 132096, GL_EBL = 134144;
#define MFMA32(a, b, c) __builtin_amdgcn_mfma_f32_32x32x16_bf16((a), (b), (c), 0, 0, 0)
#define MFMA16(a, b, c) __builtin_amdgcn_mfma_f32_16x16x32_bf16((a), (b), (c), 0, 0, 0)
__device__ __forceinline__ void gla_scan_phase(LAS unsigned char* lds, const bf16_t* proj, const float* gbuf, const float* wgu  , const float* bg  ,
                                               bf16_t* ob0, bf16_t* ob1) {
    int tid = threadIdx.x; asm volatile("" : "+v"(tid));
    const int lane = tid & 63, wave = __builtin_amdgcn_readfirstlane(tid >> 6);
    const int d = tid & 127, seg = tid >> 7;
    const int r = lane & 31, hh = lane >> 5, fr = lane & 15, fq = lane >> 4;
    for (int item = blockIdx.x; item < BATCH * 8; item += gridDim.x) {
        const int b = item >> 3, h = (item >> 1) & 3, dir = item & 1;
        bf16_t* ob = dir ? ob1 : ob0;
        const int zt = wave >> 2, zd = wave & 3;
        bf16x8 wbh, wbl;
        {
            unsigned hi_[4], lo_[4];
#pragma unroll
            for (int q = 0; q < 4; ++q) {
                const float w0 = wgu[(size_t)(dir * 16 + 8 * hh + 2 * q) * 512 + h * 128 + 32 * zd + r], w1 = wgu[(size_t)(dir * 16 + 8 * hh + 2 * q + 1) * 512 + h * 128 + 32 * zd + r];
                hi_[q] = pk2(w0, w1); lo_[q] = pk2(w0 - bflo(hi_[q]), w1 - bfhi(hi_[q]));
            }
            wbh = __builtin_bit_cast(bf16x8, (u32x4){hi_[0], hi_[1], hi_[2], hi_[3]}); wbl = __builtin_bit_cast(bf16x8, (u32x4){lo_[0], lo_[1], lo_[2], lo_[3]});
        }
        const float zbias = bg[dir * 512 + h * 128 + 32 * zd + r];
        f32x16 S[4];
#pragma unroll
        for (int kt = 0; kt < 4; ++kt)
#pragma unroll
            for (int i = 0; i < 16; ++i) S[kt][i] = 0.f;
        f32x4 gna, gnb;
        { const float* grow = gbuf + (size_t)(b * SEQ + (dir ? SEQ / 64 - 1 : 0) * 64 + 32 * zt + r) * 32 + dir * 16 + 8 * hh; gna = *(const f32x4*)grow; gnb = *(const f32x4*)(grow + 4); }
        for (int n = 0; n < SEQ / 64; ++n) {
            const int c = dir ? (SEQ / 64 - 1 - n) : n;
            const int tok0 = b * SEQ + c * 64;
            const f32x4 ga = gna, gb = gnb;
            const bf16_t* prow = proj + (size_t)(tok0 + 16 * seg) * GINP + h * 128 + d;
            unsigned short qv[16], kv[16];
#pragma unroll
            for (int ii = 0; ii < 16; ++ii) { qv[ii] = prow[(size_t)ii * GINP]; kv[ii] = prow[(size_t)ii * GINP + 512]; }
            const bf16_t* vrow = proj + (size_t)(tok0 + 16 * seg) * GINP + 1024 + h * 256 + 2 * d;
            unsigned vw[16];
#pragma unroll
            for (int ii = 0; ii < 16; ++ii) vw[ii] = *(const unsigned*)(vrow + (size_t)ii * GINP);
            {
                u32x4 ah, al;
                ah.x = pk2(ga[0], ga[1]); ah.y = pk2(ga[2], ga[3]); ah.z = pk2(gb[0], gb[1]); ah.w = pk2(gb[2], gb[3]);
                al.x = pk2(ga[0] - bflo(ah.x), ga[1] - bfhi(ah.x)); al.y = pk2(ga[2] - bflo(ah.y), ga[3] - bfhi(ah.y));
                al.z = pk2(gb[0] - bflo(ah.z), gb[1] - bfhi(ah.z)); al.w = pk2(gb[2] - bflo(ah.w), gb[3] - bfhi(ah.w));
                const bf16x8 gah = __builtin_bit_cast(bf16x8, ah), gal = __builtin_bit_cast(bf16x8, al);
                f32x16 zacc;
#pragma unroll
                for (int i = 0; i < 16; ++i) zacc[i] = zbias;
                zacc = MFMA32(gah, wbh, zacc); zacc = MFMA32(gal, wbh, zacc); zacc = MFMA32(gah, wbl, zacc);
#pragma unroll
                for (int i = 0; i < 16; ++i) *(LAS float*)(lds + GL_Z + ((32 * zt + (i & 3) + 8 * (i >> 2) + 4 * hh) * 128 + 32 * zd + r) * 4) = zacc[i];
            }
            __syncthreads();
            float cs[16];
#pragma unroll
            for (int ii = 0; ii < 16; ++ii) {
                const float z = *(const LAS float*)(lds + GL_Z + ((16 * seg + ii) * 128 + d) * 4);
                cs[ii] = fminf(z, 0.f) * (1.4426950408889634f / 16.f) - __builtin_amdgcn_logf(1.f + __builtin_amdgcn_exp2f(fabsf(z) * -1.4426950408889634f)) * (1.f / 16.f);
            }
            if (dir == 0) {
#pragma unroll
                for (int ii = 1; ii < 16; ++ii) cs[ii] += cs[ii - 1];
                *(LAS float*)(lds + GL_SEG + (seg * 128 + d) * 4) = cs[15];
            } else {
#pragma unroll
                for (int ii = 14; ii >= 0; --ii) cs[ii] += cs[ii + 1];
                *(LAS float*)(lds + GL_SEG + (seg * 128 + d) * 4) = cs[0];
            }
            __syncthreads();
            const float t0 = *(const LAS float*)(lds + GL_SEG + (0 * 128 + d) * 4), t1 = *(const LAS float*)(lds + GL_SEG + (1 * 128 + d) * 4),
                        t2 = *(const LAS float*)(lds + GL_SEG + (2 * 128 + d) * 4), t3 = *(const LAS float*)(lds + GL_SEG + (3 * 128 + d) * 4);
            const float prefix = dir == 0 ? ((seg > 0 ? t0 : 0.f) + (seg > 1 ? t1 : 0.f) + (seg > 2 ? t2 : 0.f))
                                          : ((seg < 1 ? t1 : 0.f) + (seg < 2 ? t2 : 0.f) + (seg < 3 ? t3 : 0.f));
            const float ebl = __builtin_amdgcn_exp2f((t0 + t1) + (t2 + t3));
            unsigned kd[8];
#pragma unroll
            for (int ii = 0; ii < 16; ii += 2) {
                const float e0 = __builtin_amdgcn_exp2f(prefix + cs[ii]), e1 = __builtin_amdgcn_exp2f(prefix + cs[ii + 1]);
                const float q0 = bf2f(qv[ii]), q1 = bf2f(qv[ii + 1]);
                const float k0 = bf2f(kv[ii]) * __builtin_amdgcn_rcpf(e0), k1 = bf2f(kv[ii + 1]) * __builtin_amdgcn_rcpf(e1);
                const unsigned qd = pk2(q0 * e0, q1 * e1);
                const unsigned ki = pk2(k0, k1);
                kd[ii >> 1] = pk2(k0 * ebl, k1 * ebl);
                const int i0 = 16 * seg + ii;
                *(LAS unsigned short*)(lds + GL_QD + i0 * 272 + d * 2) = (unsigned short)(qd & 0xffffu);
                *(LAS unsigned short*)(lds + GL_QD + (i0 + 1) * 272 + d * 2) = (unsigned short)(qd >> 16);
                *(LAS unsigned short*)(lds + GL_KI + i0 * 272 + d * 2) = (unsigned short)(ki & 0xffffu);
                *(LAS unsigned short*)(lds + GL_KI + (i0 + 1) * 272 + d * 2) = (unsigned short)(ki >> 16);
            }
            *(LAS u32x4*)(lds + GL_KDT + d * 144 + seg * 32) = (u32x4){kd[0], kd[1], kd[2], kd[3]};
            *(LAS u32x4*)(lds + GL_KDT + d * 144 + seg * 32 + 16) = (u32x4){kd[4], kd[5], kd[6], kd[7]};
            if (seg == 0) *(LAS float*)(lds + GL_EBL + d * 4) = ebl;
            {
                unsigned c0[8], c1[8];
#pragma unroll
                for (int t = 0; t < 8; ++t) { const unsigned a_ = vw[2 * t], b_ = vw[2 * t + 1]; c0[t] = (a_ & 0xffffu) | (b_ << 16); c1[t] = (a_ >> 16) | (b_ & 0xffff0000u); }
                *(LAS u32x4*)(lds + GL_VT + (2 * d) * 144 + seg * 32) = (u32x4){c0[0], c0[1], c0[2], c0[3]};
                *(LAS u32x4*)(lds + GL_VT + (2 * d) * 144 + seg * 32 + 16) = (u32x4){c0[4], c0[5], c0[6], c0[7]};
                *(LAS u32x4*)(lds + GL_VT + (2 * d + 1) * 144 + seg * 32) = (u32x4){c1[0], c1[1], c1[2], c1[3]};
                *(LAS u32x4*)(lds + GL_VT + (2 * d + 1) * 144 + seg * 32 + 16) = (u32x4){c1[4], c1[5], c1[6], c1[7]};
            }
            __syncthreads();
            {
                const int ti = wave >> 1;
#pragma unroll
                for (int tjj = 0; tjj < 2; ++tjj) {
                    const int tj = 2 * (wave & 1) + tjj;
                    f32x4 a4 = (f32x4){0.f, 0.f, 0.f, 0.f};
#pragma unroll
                    for (int ks = 0; ks < 4; ++ks) {
                        const bf16x8 ka = *(const LAS bf16x8*)(lds + GL_KI + (16 * tj + fr) * 272 + ks * 64 + fq * 16);
                        const bf16x8 qb = *(const LAS bf16x8*)(lds + GL_QD + (16 * ti + fr) * 272 + ks * 64 + fq * 16);
                        a4 = MFMA16(ka, qb, a4);
                    }
                    const int qi = 16 * ti + fr, kj = 16 * tj + 4 * fq;
                    float m[4];
#pragma unroll
                    for (int e = 0; e < 4; ++e) { const bool keep = dir ? (kj + e > qi) : (kj + e <= qi); m[e] = keep ? a4[e] : 0.f; }
                    u32x2 w; w.x = pk2(m[0], m[1]); w.y = pk2(m[2], m[3]);
                    *(LAS u32x2*)(lds + GL_SC + qi * 144 + kj * 2) = w;
                }
            }
            __syncthreads();
            { const int n1 = n + 1 < SEQ / 64 ? n + 1 : n; const float* grow = gbuf + (size_t)(b * SEQ + (dir ? SEQ / 64 - 1 - n1 : n1) * 64 + 32 * zt + r) * 32 + dir * 16 + 8 * hh;
              gna = *(const f32x4*)grow; gnb = *(const f32x4*)(grow + 4); }
            bf16x8 bv[4];
#pragma unroll
            for (int ks = 0; ks < 4; ++ks) bv[ks] = *(const LAS bf16x8*)(lds + GL_VT + (32 * wave + r) * 144 + ks * 32 + hh * 16);
            f32x16 oacc[2];
#pragma unroll
            for (int mt = 0; mt < 2; ++mt) {
#pragma unroll
                for (int i = 0; i < 16; ++i) oacc[mt][i] = 0.f;
#pragma unroll
                for (int ks = 0; ks < 4; ++ks) {
                    const bf16x8 a = *(const LAS bf16x8*)(lds + GL_SC + (32 * mt + r) * 144 + ks * 32 + hh * 16);
                    oacc[mt] = MFMA32(a, bv[ks], oacc[mt]);
                }
            }
#pragma unroll
            for (int kt = 0; kt < 4; ++kt)
#pragma unroll
                for (int s = 0; s < 2; ++s) {
                    u32x4 sp;
                    sp.x = pk2(S[kt][8 * s + 0], S[kt][8 * s + 1]); sp.y = pk2(S[kt][8 * s + 2], S[kt][8 * s + 3]);
                    sp.z = pk2(S[kt][8 * s + 4], S[kt][8 * s + 5]); sp.w = pk2(S[kt][8 * s + 6], S[kt][8 * s + 7]);
                    const bf16x8 sb = __builtin_bit_cast(bf16x8, sp);
#pragma unroll
                    for (int mt = 0; mt < 2; ++mt) {
                        const s16x4 lo = *(const LAS s16x4*)(lds + GL_QD + (32 * mt + r) * 272 + kt * 64 + s * 32 + hh * 8);
                        const s16x4 hi = *(const LAS s16x4*)(lds + GL_QD + (32 * mt + r) * 272 + kt * 64 + s * 32 + hh * 8 + 16);
                        const bf16x8 a = __builtin_shufflevector(lo, hi, 0, 1, 2, 3, 4, 5, 6, 7);
                        oacc[mt] = MFMA32(a, sb, oacc[mt]);
                    }
                }
            {
                bf16_t* obase = ob + (size_t)(tok0 + 4 * hh) * DM + h * 256 + 32 * wave + r;
#pragma unroll
                for (int mt = 0; mt < 2; ++mt)
#pragma unroll
                    for (int i = 0; i < 16; ++i) {
                        const int row = 32 * mt + (i & 3) + 8 * (i >> 2);
                        obase[(size_t)row * DM] = (bf16_t)(pk2(oacc[mt][i], 0.f) & 0xffffu);
                    }
            }
#pragma unroll
            for (int kt = 0; kt < 4; ++kt) {
#pragma unroll
                for (int g4 = 0; g4 < 4; ++g4) {
                    const f32x4 e4 = *(const LAS f32x4*)(lds + GL_EBL + (32 * kt + 8 * g4 + 4 * hh) * 4);
#pragma unroll
                    for (int e = 0; e < 4; ++e) S[kt][4 * g4 + e] *= e4[e];
                }
#pragma unroll
                for (int ks = 0; ks < 4; ++ks) {
                    const bf16x8 a = *(const LAS bf16x8*)(lds + GL_KDT + (32 * kt + r) * 144 + ks * 32 + hh * 16);
                    S[kt] = MFMA32(a, bv[ks], S[kt]);
                }
            }
        }
        __syncthreads();
    }
}

constexpr int G2_SET = 43008, G2_QD = 0, G2_KDT = 8704, G2_VT = 18944, G2_SC = 39424, G2_EBL = 41984;
constexpr int G2_KI = 2 * G2_SET, G2_Z = G2_KI + 8704, G2_SEG = G2_Z + 16384;
#define G2_BAR() do { asm volatile("s_waitcnt lgkmcnt(0)" ::: "memory"); __builtin_amdgcn_s_barrier(); asm volatile("" ::: "memory"); } while (0)
__device__ __forceinline__ void gla_scan_phase2(LAS unsigned char* lds, const bf16_t* proj, const float* gbuf, const float* wgu  , const float* bg  ,
                                                bf16_t* ob0, bf16_t* ob1) {
    int tid = threadIdx.x; asm volatile("" : "+v"(tid));
    const int lane = tid & 63, wave = __builtin_amdgcn_readfirstlane(tid >> 6);
    const int r = lane & 31, hh = lane >> 5, fr = lane & 15, fq = lane >> 4;
    constexpr int CH = 32, NCH = SEQ / CH;
    for (int item = blockIdx.x; item < BATCH * 8; item += gridDim.x) {
        const int b = item >> 3, h = (item >> 1) & 3, dir = item & 1;
        if (wave < 4) {
            const int d = tid & 127, seg = (tid >> 7) & 1;
            const int zd = wave;
            bf16x8 wbh, wbl;
            {
                unsigned hi_[4], lo_[4];
#pragma unroll
                for (int q = 0; q < 4; ++q) {
                    const float w0 = wgu[(size_t)(dir * 16 + 8 * hh + 2 * q) * 512 + h * 128 + 32 * zd + r], w1 = wgu[(size_t)(dir * 16 + 8 * hh + 2 * q + 1) * 512 + h * 128 + 32 * zd + r];
                    hi_[q] = pk2(w0, w1); lo_[q] = pk2(w0 - bflo(hi_[q]), w1 - bfhi(hi_[q]));
                }
                wbh = __builtin_bit_cast(bf16x8, (u32x4){hi_[0], hi_[1], hi_[2], hi_[3]}); wbl = __builtin_bit_cast(bf16x8, (u32x4){lo_[0], lo_[1], lo_[2], lo_[3]});
            }
            const float zbias = bg[dir * 512 + h * 128 + 32 * zd + r];
            const __amdgpu_buffer_rsrc_t prs = __builtin_amdgcn_make_buffer_rsrc((void*)proj, 0, (unsigned)((size_t)MTOK * GINP * 2), 0x00020000);
            const unsigned qvoff = (unsigned)((16 * seg * GINP + h * 128 + d) * 2), vvoff = (unsigned)((16 * seg * GINP + 1024 + h * 256 + 2 * d) * 2);
            f32x4 gna, gnb;
            { const float* grow = gbuf + (size_t)(b * SEQ + (dir ? NCH - 1 : 0) * CH + r) * 32 + dir * 16 + 8 * hh; gna = *(const f32x4*)grow; gnb = *(const f32x4*)(grow + 4); }
            for (int n = 0; n <= NCH; ++n) {
                if (n < NCH) {
                    const int tok0 = b * SEQ + (dir ? NCH - 1 - n : n) * CH;
                    LAS unsigned char* set = lds + (n & 1) * G2_SET;
                    const f32x4 ga = gna, gb = gnb;
                    const unsigned srow = (unsigned)tok0 * (unsigned)(GINP * 2);
                    unsigned short qv[16], kv[16];
#pragma unroll
                    for (int ii = 0; ii < 16; ++ii) { qv[ii] = __builtin_amdgcn_raw_buffer_load_b16(prs, qvoff, srow + (unsigned)(ii * GINP * 2), 0);
                                                       kv[ii] = __builtin_amdgcn_raw_buffer_load_b16(prs, qvoff + 1024u, srow + (unsigned)(ii * GINP * 2), 0); }
                    unsigned vw[16];
#pragma unroll
                    for (int ii = 0; ii < 16; ++ii) vw[ii] = __builtin_amdgcn_raw_buffer_load_b32(prs, vvoff, srow + (unsigned)(ii * GINP * 2), 0);
                    { const int n1 = n + 1 < NCH ? n + 1 : n; const float* grow = gbuf + (size_t)(b * SEQ + (dir ? NCH - 1 - n1 : n1) * CH + r) * 32 + dir * 16 + 8 * hh;
                      gna = *(const f32x4*)grow; gnb = *(const f32x4*)(grow + 4); }
                    {
                        u32x4 ah, al;
                        ah.x = pk2(ga[0], ga[1]); ah.y = pk2(ga[2], ga[3]); ah.z = pk2(gb[0], gb[1]); ah.w = pk2(gb[2], gb[3]);
                        al.x = pk2(ga[0] - bflo(ah.x), ga[1] - bfhi(ah.x)); al.y = pk2(ga[2] - bflo(ah.y), ga[3] - bfhi(ah.y));
                        al.z = pk2(gb[0] - bflo(ah.z), gb[1] - bfhi(ah.z)); al.w = pk2(gb[2] - bflo(ah.w), gb[3] - bfhi(ah.w));
                        const bf16x8 gah = __builtin_bit_cast(bf16x8, ah), gal = __builtin_bit_cast(bf16x8, al);
                        f32x16 zacc;
#pragma unroll
                        for (int i = 0; i < 16; ++i) zacc[i] = zbias;
                        zacc = MFMA32(gah, wbh, zacc); zacc = MFMA32(gal, wbh, zacc); zacc = MFMA32(gah, wbl, zacc);
#pragma unroll
                        for (int i = 0; i < 16; ++i) *(LAS float*)(lds + G2_Z + (((i & 3) + 8 * (i >> 2) + 4 * hh) * 128 + 32 * zd + r) * 4) = zacc[i];
                    }
                    G2_BAR();
                    float cs[16];
#pragma unroll
                    for (int ii = 0; ii < 16; ++ii) {
                        const float z = *(const LAS float*)(lds + G2_Z + ((16 * seg + ii) * 128 + d) * 4);
                        cs[ii] = fminf(z, 0.f) * (1.4426950408889634f / 16.f) - __builtin_amdgcn_logf(1.f + __builtin_amdgcn_exp2f(fabsf(z) * -1.4426950408889634f)) * (1.f / 16.f);
                    }
                    if (dir == 0) {
#pragma unroll
                        for (int ii = 1; ii < 16; ++ii) cs[ii] += cs[ii - 1];
                        *(LAS float*)(lds + G2_SEG + (seg * 128 + d) * 4) = cs[15];
                    } else {
#pragma unroll
                        for (int ii = 14; ii >= 0; --ii) cs[ii] += cs[ii + 1];
                        *(LAS float*)(lds + G2_SEG + (seg * 128 + d) * 4) = cs[0];
                    }
                    G2_BAR();
                    {
                        const float t0 = *(const LAS float*)(lds + G2_SEG + d * 4), t1 = *(const LAS float*)(lds + G2_SEG + (128 + d) * 4);
                        const float prefix = dir == 0 ? (seg ? t0 : 0.f) : (seg ? 0.f : t1);
                        const float ebl = __builtin_amdgcn_exp2f(t0 + t1);
                        unsigned kd[8];
#pragma unroll
                        for (int ii = 0; ii < 16; ii += 2) {
                            const float e0 = __builtin_amdgcn_exp2f(prefix + cs[ii]), e1 = __builtin_amdgcn_exp2f(prefix + cs[ii + 1]);
                            const float q0 = bf2f(qv[ii]), q1 = bf2f(qv[ii + 1]);
                            const float k0 = bf2f(kv[ii]) * __builtin_amdgcn_rcpf(e0), k1 = bf2f(kv[ii + 1]) * __builtin_amdgcn_rcpf(e1);
                            const unsigned qd = pk2(q0 * e0, q1 * e1);
                            const unsigned ki = pk2(k0, k1);
                            kd[ii >> 1] = pk2(k0 * ebl, k1 * ebl);
                            const int i0 = 16 * seg + ii;
                            *(LAS unsigned short*)(set + G2_QD + i0 * 272 + d * 2) = (unsigned short)(qd & 0xffffu);
                            *(LAS unsigned short*)(set + G2_QD + (i0 + 1) * 272 + d * 2) = (unsigned short)(qd >> 16);
                            *(LAS unsigned short*)(lds + G2_KI + i0 * 272 + d * 2) = (unsigned short)(ki & 0xffffu);
                            *(LAS unsigned short*)(lds + G2_KI + (i0 + 1) * 272 + d * 2) = (unsigned short)(ki >> 16);
                        }
                        *(LAS u32x4*)(set + G2_KDT + d * 80 + seg * 32) = (u32x4){kd[0], kd[1], kd[2], kd[3]};
                        *(LAS u32x4*)(set + G2_KDT + d * 80 + seg * 32 + 16) = (u32x4){kd[4], kd[5], kd[6], kd[7]};
                        if (seg == 0) *(LAS float*)(set + G2_EBL + d * 4) = ebl;
                        unsigned c0[8], c1[8];
#pragma unroll
                        for (int t = 0; t < 8; ++t) { const unsigned a_ = vw[2 * t], b_ = vw[2 * t + 1]; c0[t] = (a_ & 0xffffu) | (b_ << 16); c1[t] = (a_ >> 16) | (b_ & 0xffff0000u); }
                        *(LAS u32x4*)(set + G2_VT + (2 * d) * 80 + seg * 32) = (u32x4){c0[0], c0[1], c0[2], c0[3]};
                        *(LAS u32x4*)(set + G2_VT + (2 * d) * 80 + seg * 32 + 16) = (u32x4){c0[4], c0[5], c0[6], c0[7]};
                        *(LAS u32x4*)(set + G2_VT + (2 * d + 1) * 80 + seg * 32) = (u32x4){c1[0], c1[1], c1[2], c1[3]};
                        *(LAS u32x4*)(set + G2_VT + (2 * d + 1) * 80 + seg * 32 + 16) = (u32x4){c1[4], c1[5], c1[6], c1[7]};
                    }
                    G2_BAR();
                    {
                        const int ti = wave >> 1, tj = wave & 1;
                        f32x4 a4 = (f32x4){0.f, 0.f, 0.f, 0.f};
#pragma unroll
                        for (int ks = 0; ks < 4; ++ks) {
                            const bf16x8 ka = *(const LAS bf16x8*)(lds + G2_KI + (16 * tj + fr) * 272 + ks * 64 + fq * 16);
                            const bf16x8 qb = *(const LAS bf16x8*)(set + G2_QD + (16 * ti + fr) * 272 + ks * 64 + fq * 16);
                            a4 = MFMA16(ka, qb, a4);
                        }
                        const int qi = 16 * ti + fr, kj = 16 * tj + 4 * fq;
                        float m[4];
#pragma unroll
                        for (int e = 0; e < 4; ++e) { const bool keep = dir ? (kj + e > qi) : (kj + e <= qi); m[e] = keep ? a4[e] : 0.f; }
                        u32x2 w; w.x = pk2(m[0], m[1]); w.y = pk2(m[2], m[3]);
                        *(LAS u32x2*)(set + G2_SC + qi * 80 + kj * 2) = w;
                    }
                    G2_BAR();
                } else { G2_BAR(); G2_BAR(); G2_BAR(); G2_BAR(); }
            }
        } else {
            const int cw = wave - 4;
            bf16_t* ob = dir ? ob1 : ob0;
            const __amdgpu_buffer_rsrc_t ors = __builtin_amdgcn_make_buffer_rsrc((void*)ob, 0, (unsigned)((size_t)MTOK * DM * 2), 0x00020000);
            const unsigned ovoff = (unsigned)((r * DM + h * 256 + 64 * cw + 4 * hh) * 2);
            f32x16 S[2][4];
#pragma unroll
            for (int nt2 = 0; nt2 < 2; ++nt2)
#pragma unroll
                for (int kt = 0; kt < 4; ++kt)
#pragma unroll
                    for (int i = 0; i < 16; ++i) S[nt2][kt][i] = 0.f;
            for (int n = 0; n <= NCH; ++n) {
                if (n >= 1) {
                    const int mch = n - 1;
                    const int tok0 = b * SEQ + (dir ? NCH - 1 - mch : mch) * CH;
                    const LAS unsigned char* set = lds + (mch & 1) * G2_SET;
                    bf16x8 bv[2][2];
#pragma unroll
                    for (int nt2 = 0; nt2 < 2; ++nt2)
#pragma unroll
                        for (int ks = 0; ks < 2; ++ks) bv[nt2][ks] = *(const LAS bf16x8*)(set + G2_VT + (64 * cw + 32 * nt2 + r) * 80 + ks * 32 + hh * 16);
                    f32x16 oacc[2];
#pragma unroll
                    for (int nt2 = 0; nt2 < 2; ++nt2)
#pragma unroll
                        for (int i = 0; i < 16; ++i) oacc[nt2][i] = 0.f;
#pragma unroll
                    for (int ks = 0; ks < 2; ++ks) {
                        const bf16x8 a = *(const LAS bf16x8*)(set + G2_SC + r * 80 + ks * 32 + hh * 16);
#pragma unroll
                        for (int nt2 = 0; nt2 < 2; ++nt2) oacc[nt2] = MFMA32(bv[nt2][ks], a, oacc[nt2]);
                    }
#define G2_OINTER(KT) do { _Pragma("unroll") for (int s = 0; s < 2; ++s) { __builtin_amdgcn_sched_barrier(0); \
                        const s16x4 lo = *(const LAS s16x4*)(set + G2_QD + r * 272 + (KT) * 64 + s * 32 + hh * 8); \
                        const s16x4 hi = *(const LAS s16x4*)(set + G2_QD + r * 272 + (KT) * 64 + s * 32 + hh * 8 + 16); \
                        const bf16x8 a = __builtin_shufflevector(lo, hi, 0, 1, 2, 3, 4, 5, 6, 7); \
                        _Pragma("unroll") for (int nt2 = 0; nt2 < 2; ++nt2) { u32x4 sp; \
                            sp.x = pk2(S[nt2][KT][8 * s + 0], S[nt2][KT][8 * s + 1]); sp.y = pk2(S[nt2][KT][8 * s + 2], S[nt2][KT][8 * s + 3]); \
                            sp.z = pk2(S[nt2][KT][8 * s + 4], S[nt2][KT][8 * s + 5]); sp.w = pk2(S[nt2][KT][8 * s + 6], S[nt2][KT][8 * s + 7]); \
                            oacc[nt2] = MFMA32(__builtin_bit_cast(bf16x8, sp), a, oacc[nt2]); } } } while (0)
                    G2_OINTER(0);
                    G2_BAR();
                    G2_OINTER(1); G2_OINTER(2);
                    G2_BAR();
                    G2_OINTER(3);
                    {
                        const unsigned orow = (unsigned)tok0 * (unsigned)(DM * 2);
#pragma unroll
                        for (int nt2 = 0; nt2 < 2; ++nt2)
#pragma unroll
                            for (int g = 0; g < 4; ++g) {
                                u32x2 w; w.x = pk2(oacc[nt2][4 * g], oacc[nt2][4 * g + 1]); w.y = pk2(oacc[nt2][4 * g + 2], oacc[nt2][4 * g + 3]);
                                __builtin_amdgcn_raw_buffer_store_b64(w, ors, ovoff + (unsigned)((32 * nt2 + 8 * g) * 2), orow, 0);
                            }
                    }
#define G2_STATE(KT) do { \
                        _Pragma("unroll") for (int g4 = 0; g4 < 4; ++g4) { const f32x4 e4 = *(const LAS f32x4*)(set + G2_EBL + (32 * (KT) + 8 * g4 + 4 * hh) * 4); \
                            _Pragma("unroll") for (int nt2 = 0; nt2 < 2; ++nt2) _Pragma("unroll") for (int e = 0; e < 4; ++e) S[nt2][KT][4 * g4 + e] *= e4[e]; } \
                        _Pragma("unroll") for (int ks = 0; ks < 2; ++ks) { const bf16x8 a = *(const LAS bf16x8*)(set + G2_KDT + (32 * (KT) + r) * 80 + ks * 32 + hh * 16); \
                            _Pragma("unroll") for (int nt2 = 0; nt2 < 2; ++nt2) S[nt2][KT] = MFMA32(a, bv[nt2][ks], S[nt2][KT]); } } while (0)
                    G2_STATE(0); G2_STATE(1);
                    G2_BAR();
                    G2_STATE(2); G2_STATE(3);
#undef G2_STATE
                    G2_BAR();
#undef G2_OINTER
                } else { G2_BAR(); G2_BAR(); G2_BAR(); G2_BAR(); }
            }
        }
        G2_BAR();
    }
}

__device__ __forceinline__ void gla_post_phase(const bf16_t* ob0, const bf16_t* ob1, const bf16_t* proj, const float* hgain, bf16_t* a2) {
    int tid = threadIdx.x; asm volatile("" : "+v"(tid));
    const int lane = tid & 63, wave = __builtin_amdgcn_readfirstlane(tid >> 6);
    const int gw = blockIdx.x * NWAVES + wave, NGW = gridDim.x * NWAVES;
    const int hp = lane >> 5, c8 = (lane & 31) * 8;
    const f32x4 hg0 = *(const f32x4*)(hgain + c8), hg1 = *(const f32x4*)(hgain + c8 + 4);
    u32x4 a[2], b[2], rr[2], na[2], nb[2], nr[2];
#define POST_LOAD(A_, B_, R_, row_) do { _Pragma("unroll") for (int ps = 0; ps < 2; ++ps) { const size_t off_ = (size_t)(row_) * DM + (2 * ps + hp) * 256 + c8; \
        A_[ps] = *(const u32x4*)(ob0 + off_); B_[ps] = *(const u32x4*)(ob1 + off_); R_[ps] = *(const u32x4*)(proj + (size_t)(row_) * GINP + 2048 + (2 * ps + hp) * 256 + c8); } } while (0)
    if (gw < MTOK) POST_LOAD(a, b, rr, gw);
    if (gw + NGW < MTOK) POST_LOAD(na, nb, nr, gw + NGW);
    for (int row = gw; row < MTOK; row += NGW) {
        u32x4 ca[2], cb[2], cr[2];
#pragma unroll
        for (int ps = 0; ps < 2; ++ps) { ca[ps] = a[ps]; cb[ps] = b[ps]; cr[ps] = rr[ps]; a[ps] = na[ps]; b[ps] = nb[ps]; rr[ps] = nr[ps]; }
        if (row + 2 * NGW < MTOK) POST_LOAD(na, nb, nr, row + 2 * NGW);
#pragma unroll
        for (int ps = 0; ps < 2; ++ps) {
            float o[8];
#pragma unroll
            for (int q = 0; q < 4; ++q) { o[2 * q] = bflo(ca[ps][q]) + bflo(cb[ps][q]); o[2 * q + 1] = bfhi(ca[ps][q]) + bfhi(cb[ps][q]); }
            float ss = 0.f;
#pragma unroll
            for (int q = 0; q < 8; ++q) ss += o[q] * o[q];
#pragma unroll
            for (int sh = 1; sh < 32; sh <<= 1) ss += __shfl_xor(ss, sh);
            const float rs = rsqrtf(ss * (1.f / 256.f) + EPS);
            u32x4 w;
            w.x = pk2(o[0] * rs * hg0[0] * silu_f(bflo(cr[ps].x)), o[1] * rs * hg0[1] * silu_f(bfhi(cr[ps].x)));
            w.y = pk2(o[2] * rs * hg0[2] * silu_f(bflo(cr[ps].y)), o[3] * rs * hg0[3] * silu_f(bfhi(cr[ps].y)));
            w.z = pk2(o[4] * rs * hg1[0] * silu_f(bflo(cr[ps].z)), o[5] * rs * hg1[1] * silu_f(bfhi(cr[ps].z)));
            w.w = pk2(o[6] * rs * hg1[2] * silu_f(bflo(cr[ps].w)), o[7] * rs * hg1[3] * silu_f(bfhi(cr[ps].w)));
            *(u32x4*)(a2 + (size_t)row * DM + (2 * ps + hp) * 256 + c8) = w;
        }
    }
#undef POST_LOAD
}

__device__ __forceinline__ void final_norm_phase(float* out, const bf16_t* xb, const float* ssq, const float* gain) {
    int tid = threadIdx.x; asm volatile("" : "+v"(tid));
    const int lane = tid & 63, wave = __builtin_amdgcn_readfirstlane(tid >> 6);
    const int gw = blockIdx.x * NWAVES + wave, NGW = gridDim.x * NWAVES;
    f32x4 g[4];
#pragma unroll
    for (int j = 0; j < 2; ++j) { g[2 * j] = *(const f32x4*)(gain + 512 * j + 8 * lane); g[2 * j + 1] = *(const f32x4*)(gain + 512 * j + 8 * lane + 4); }
    u32x4 w[2]; f32x4 sq;
#define FIN_LOAD(row_) do { w[0] = *(const u32x4*)(xb + (size_t)(row_) * DM + 8 * lane); w[1] = *(const u32x4*)(xb + (size_t)(row_) * DM + 512 + 8 * lane); sq = *(const f32x4*)(ssq + (size_t)(row_) * 4); } while (0)
    if (gw < MTOK) FIN_LOAD(gw);
    for (int row = gw; row < MTOK; row += NGW) {
        const u32x4 c0 = w[0], c1 = w[1]; const float rs = rsqrtf(((sq.x + sq.y) + (sq.z + sq.w)) * (1.f / 1024.f) + EPS);
        if (row + NGW < MTOK) FIN_LOAD(row + NGW);
        float* orow = out + (size_t)row * DM + 8 * lane;
        *(f32x4*)(orow) = (f32x4){bflo(c0.x), bfhi(c0.x), bflo(c0.y), bfhi(c0.y)} * rs * g[0];
        *(f32x4*)(orow + 4) = (f32x4){bflo(c0.z), bfhi(c0.z), bflo(c0.w), bfhi(c0.w)} * rs * g[1];
        *(f32x4*)(orow + 512) = (f32x4){bflo(c1.x), bfhi(c1.x), bflo(c1.y), bfhi(c1.y)} * rs * g[2];
        *(f32x4*)(orow + 516) = (f32x4){bflo(c1.z), bfhi(c1.z), bflo(c1.w), bfhi(c1.w)} * rs * g[3];
    }
#undef FIN_LOAD
}

#define XB_TMO      128
#define XB_XCNT(j)  (256  + 64 * (j))
#define XB_XSUB(j)  (1280 + 64 * (j))
#define XB_XGEN(j)  (2304 + 64 * (j))
#define XB_TOP      3328
#define XB_TOPGEN   3392
#define XCD_BAR_WORDS 3456
#define XB_SPIN_CAP (1u << 22)
__device__ __forceinline__ unsigned xb_ld(unsigned* p)              { return __hip_atomic_load(p, __ATOMIC_RELAXED, __HIP_MEMORY_SCOPE_AGENT); }
__device__ __forceinline__ unsigned xb_add(unsigned* p, unsigned v) { return __hip_atomic_fetch_add(p, v, __ATOMIC_RELAXED, __HIP_MEMORY_SCOPE_AGENT); }
__device__ __forceinline__ unsigned xb_xcc_id() { return (unsigned)__builtin_amdgcn_s_getreg((3 << 11) | 20) & 0xFu; }
#define XB_SPIN(cond, bar) do { unsigned _sp = 0; while (cond) { __builtin_amdgcn_s_sleep(1); \
    if ((++_sp & 255u) == 0u) { if (xb_ld(&(bar)[XB_TMO])) break; if (_sp > XB_SPIN_CAP) { atomicAdd(&(bar)[XB_TMO], 1u); break; } } } } while (0)
struct XcdBarrier { unsigned* bar; unsigned x; volatile LAS unsigned* st; };
__device__ __forceinline__ XcdBarrier xcd_barrier_post(unsigned* bar, volatile LAS unsigned* st) {
    XcdBarrier b; b.bar = bar; b.x = xb_xcc_id(); b.st = st;
    if (threadIdx.x == 0) (void)xb_add(&bar[XB_XCNT(b.x)], 1u);
    return b;
}
__device__ __forceinline__ void xcd_barrier_complete(unsigned* bar, unsigned x, unsigned& nloc, unsigned& nx) {
    const unsigned G = gridDim.x * gridDim.y * gridDim.z;
    unsigned sum, cnt, mine, sp = 0u;
    for (;;) {
        sum = 0u; cnt = 0u; mine = 0u;
#pragma unroll
        for (unsigned j = 0; j < 16; ++j) { const unsigned c = xb_ld(&bar[XB_XCNT(j)]); sum += c; cnt += (c > 0u) ? 1u : 0u; mine = (j == x) ? c : mine; }
        if (sum == G) break;
        __builtin_amdgcn_s_sleep(1);
        if ((++sp & 255u) == 0u) { if (xb_ld(&bar[XB_TMO])) break; if (sp > XB_SPIN_CAP) { atomicAdd(&bar[XB_TMO], 1u); break; } }
    }
    nloc = mine > 0u ? mine : 1u; nx = cnt > 0u ? cnt : 1u;
}
__device__ __forceinline__ void xcd_barrier(const XcdBarrier& b) {
    asm volatile("s_waitcnt vmcnt(0)" ::: "memory");
    __syncthreads();
    if (threadIdx.x == 0) {
        unsigned* bar = b.bar;
        __builtin_amdgcn_s_waitcnt(0);
        unsigned nloc = b.st[0], nx = b.st[1];
        if (nloc == 0u) { xcd_barrier_complete(bar, b.x, nloc, nx); b.st[0] = nloc; b.st[1] = nx; }
        const unsigned old = xb_add(&bar[XB_XSUB(b.x)], 1u);
        const unsigned gen = old / nloc;
        if (old + 1u == (gen + 1u) * nloc) {
            __builtin_amdgcn_fence(__ATOMIC_RELEASE, "agent");
            asm volatile("s_waitcnt vmcnt(0)" ::: "memory");
            const unsigned og = xb_add(&bar[XB_TOP], 1u);
            const unsigned tg = og / nx;
            if (og + 1u == (tg + 1u) * nx) xb_add(&bar[XB_TOPGEN], 1u);
            else XB_SPIN(xb_ld(&bar[XB_TOPGEN]) == tg, bar);
            __builtin_amdgcn_fence(__ATOMIC_ACQUIRE, "agent");
            xb_add(&bar[XB_XGEN(b.x)], 1u);
            asm volatile("s_waitcnt vmcnt(0)" ::: "memory");
        } else {
            XB_SPIN(xb_ld(&bar[XB_XGEN(b.x)]) == gen, bar);
            __builtin_amdgcn_fence(__ATOMIC_ACQUIRE, "agent");
            asm volatile("s_waitcnt vmcnt(0)" ::: "memory");
        }
    }
    __syncthreads();
}

__device__ __forceinline__ void rstd_cache_reset(LAS unsigned char* lds) {
    int tid = threadIdx.x; asm volatile("" : "+v"(tid));
    if (tid < 4) ((volatile LAS int*)(lds + pg8::STAGE_BYTES + 8208))[tid] = -1;
    __syncthreads();
}
__global__ void __launch_bounds__(NTHREADS, 2) fwd_megakernel(Params p) {
    extern __shared__ __attribute__((aligned(16))) unsigned char lds_raw[];
    LAS unsigned char* lds = (LAS unsigned char*)lds_raw;
    cg::grid_group grid = cg::this_grid();
    const int G = gridDim.x, bx = blockIdx.x;
    unsigned char* ws = p.ws;
    float* ssq = (float*)(ws + WS_SSQ);
    float* gbuf = (float*)(ws + WS_GBUF);
    bf16_t* XB = (bf16_t*)(ws + WS_XB);
    bf16_t* R2 = (bf16_t*)(ws + WS_R2);
    bf16_t* OB1 = (bf16_t*)(ws + WS_OB1);
    bf16_t* OB0 = (bf16_t*)p.out;
    bf16_t* R1 = (bf16_t*)(ws + WS_R1);
    if (threadIdx.x < 2) ((volatile LAS unsigned*)(lds + 139264))[threadIdx.x] = 0u;
    __syncthreads();
    const XcdBarrier xbar = xcd_barrier_post((unsigned*)ws, (volatile LAS unsigned*)(lds + 139264));
#define GRID_SYNC() xcd_barrier(xbar)

    p0_phase(p, lds);
    grid.sync();

#pragma unroll 1
    for (int layer = 0; layer < 4; ++layer) {
        const int j = layer >> 1;
        if ((layer & 1) == 0) {
            pool_prep_phase(lds, XB, ssq, p.norm_mix + layer * DM, R2);
            GRID_SYNC();
            { pg8::Gemm g{R2, (const bf16_t*)(ws + WS_WPOOL + j * SZ_WPOOL), 256, DM, 256, 256}; pg8::StaticOrder S; S.init(MTOK, DM, G, bx);
              pg8::EpiRes E{XB, XB, ssq};
              pg8::gemm_phase<pg8::EpiRes, pg8::StaticOrder>(lds, g, S, E); }
            GRID_SYNC();
        } else {
            rstd_cache_reset(lds);
            { pg8::Gemm g{XB, (const bf16_t*)(ws + WS_WIN + j * SZ_WIN), DM, DM, DM, 0}; pg8::StaticOrder S; S.init(MTOK, GINP, G, bx);
              pg8::EpiProj E{R1, gbuf, ssq};
              pg8::gemm_phase<pg8::EpiProj, pg8::StaticOrder>(lds, g, S, E);
            }
            GRID_SYNC();
            gla_scan_phase2(lds, R1, gbuf, p.w_gate_up + (size_t)j * 2 * 16 * 512, p.b_gate + (size_t)j * 2 * 512, OB0, OB1);
            GRID_SYNC();
            gla_post_phase(OB0, OB1, R1, p.gla_head_norm + j * 256, R2);
            GRID_SYNC();
            { pg8::Gemm g{R2, (const bf16_t*)(ws + WS_WOUT + j * SZ_WOUT), DM, DM, DM, 0}; pg8::StaticOrder S; S.init(MTOK, DM, G, bx);
              pg8::EpiRes E{XB, XB, ssq};
              pg8::gemm_phase<pg8::EpiRes, pg8::StaticOrder>(lds, g, S, E); }
            GRID_SYNC();
        }
        rstd_cache_reset(lds);
        { pg8::Gemm g{XB, (const bf16_t*)(ws + WS_WGU + layer * SZ_WGU), DM, DM, DM, 0}; pg8::StaticOrder S; S.init(MTOK, NGU, G, bx);
          pg8::EpiGU E{R1, ssq};
          pg8::gemm_phase<pg8::EpiGU, pg8::StaticOrder>(lds, g, S, E);
        }
        GRID_SYNC();
        { pg8::Gemm g{R1, (const bf16_t*)(ws + WS_WD + layer * SZ_WD), DFF, DFF, DFF, 0}; pg8::StaticOrder S; S.init(MTOK, DM, G, bx); S.rev = (S.nwg % G) == 0;
          pg8::EpiRes E{XB, XB, ssq};
          pg8::gemm_phase<pg8::EpiRes, pg8::StaticOrder>(lds, g, S, E); }
        GRID_SYNC();
    }
    final_norm_phase(p.out, XB, ssq, p.norm_final);
}

extern "C" void kernel_launch(void* const* d_in, const int* in_sizes, int n_in, void* d_out, int out_size, void* d_ws, size_t ws_size, hipStream_t stream) {
    static int grid = 0;
    if (grid == 0) {
        if (n_in != 14 || in_sizes[0] != MTOK * DM || out_size != MTOK * DM || ws_size < WS_END) {
            fprintf(stderr, "kernel_launch: unexpected shapes (n_in %d, in0 %d, out %d, ws %zu, need %zu); nothing launched\n", n_in, n_in > 0 ? in_sizes[0] : -1, out_size, ws_size, (size_t)WS_END);
            grid = -1; return;
        }
        int dev = 0, cus = 0, per_cu = 0;
        (void)hipGetDevice(&dev);
        (void)hipDeviceGetAttribute(&cus, hipDeviceAttributeMultiprocessorCount, dev);
        if (hipFuncSetAttribute((const void*)fwd_megakernel, hipFuncAttributeMaxDynamicSharedMemorySize, LDS_BYTES) != hipSuccess) { fprintf(stderr, "kernel_launch: hipFuncSetAttribute failed\n"); grid = -1; return; }
        if (hipOccupancyMaxActiveBlocksPerMultiprocessor(&per_cu, (const void*)fwd_megakernel, NTHREADS, LDS_BYTES) != hipSuccess || per_cu < 1) {
            fprintf(stderr, "kernel_launch: occupancy query says %d blocks per CU; using 1\n", per_cu); per_cu = 1; (void)hipGetLastError();
        }
        grid = cus * 1;
        fprintf(stderr, "kernel_launch: grid %d (cus %d, per_cu %d)\n", grid, cus, per_cu);
    }
    if (grid < 0) return;
    if (hipMemsetAsync(d_ws, 0, 16384, stream) != hipSuccess) { fprintf(stderr, "kernel_launch: memset failed\n"); return; }
    Params p{};
    p.x = (const float*)d_in[0]; p.norm_mix = (const float*)d_in[1]; p.norm_ffn = (const float*)d_in[2]; p.norm_final = (const float*)d_in[3];
    p.w_pool = (const float*)d_in[4]; p.pool_scale = (const float*)d_in[5]; p.w_gla_in = (const float*)d_in[6]; p.w_gate_up = (const float*)d_in[7];
    p.b_gate = (const float*)d_in[8]; p.gla_head_norm = (const float*)d_in[9]; p.w_gla_out = (const float*)d_in[10]; p.w_ffn_gate = (const float*)d_in[11];
    p.w_ffn_up = (const float*)d_in[12]; p.w_ffn_down = (const float*)d_in[13];
    p.out = (float*)d_out; p.ws = (unsigned char*)d_ws;
    void* args[] = {&p};
    hipError_t e = hipLaunchCooperativeKernel((const void*)fwd_megakernel, dim3(grid), dim3(NTHREADS), args, LDS_BYTES, stream);
    if (e != hipSuccess) fprintf(stderr, "kernel_launch: cooperative launch failed: %s (grid %d)\n", hipGetErrorString(e), grid);
}
```

```cpp
#include <hip/hip_runtime.h>
#include <hip/hip_cooperative_groups.h>
#include <cstdio>
#include <cstdint>
namespace cg = cooperative_groups;

#define LAS __attribute__((address_space(3)))
typedef unsigned short bf16_t;
typedef short bf16x8 __attribute__((ext_vector_type(8)));
typedef short s16x4 __attribute__((ext_vector_type(4)));
typedef float f32x4 __attribute__((ext_vector_type(4)));
typedef float f32x16 __attribute__((ext_vector_type(16)));
typedef float f32x2 __attribute__((ext_vector_type(2)));
typedef __bf16 bf16x2_t __attribute__((ext_vector_type(2)));
typedef unsigned u32x4 __attribute__((ext_vector_type(4)));
typedef unsigned u32x2 __attribute__((ext_vector_type(2)));

constexpr int DM = 1024, BATCH = 32, SEQ = 2048, MTOK = BATCH * SEQ, DFF = 2816, NGU = 2 * DFF, GIN = 3104, GINP = 3328;
constexpr int NWAVES = 8, NTHREADS = 512;
constexpr float EPS = 1e-6f;

constexpr size_t MiB = 1u << 20;
constexpr size_t SZ_WGU = (size_t)NGU * DM * 2, SZ_WD = (size_t)DM * DFF * 2, SZ_WIN = (size_t)GINP * DM * 2, SZ_WOUT = (size_t)DM * DM * 2, SZ_WPOOL = (size_t)DM * 256 * 2;
constexpr size_t WS_WGU = 1 * MiB, WS_WD = WS_WGU + 4 * SZ_WGU, WS_WIN = WS_WD + 4 * SZ_WD, WS_WOUT = WS_WIN + 2 * SZ_WIN, WS_WPOOL = WS_WOUT + 2 * SZ_WOUT, WS_WEND = WS_WPOOL + 2 * SZ_WPOOL;
static_assert(WS_WEND <= 100 * MiB, "weights");
constexpr size_t WS_SSQ = 100 * MiB;
constexpr size_t WS_GBUF = 104 * MiB;
constexpr size_t WS_XB = 112 * MiB;
constexpr size_t WS_R2 = 240 * MiB;
constexpr size_t WS_OB1 = 368 * MiB;
constexpr size_t WS_R1 = 496 * MiB;
constexpr size_t WS_END = 912 * MiB;

constexpr int LDS_BYTES = 147456;

__device__ __forceinline__ unsigned pk2(float lo, float hi) { f32x2 v = {lo, hi}; bf16x2_t b = __builtin_convertvector(v, bf16x2_t); return __builtin_bit_cast(unsigned, b); }
__device__ __forceinline__ float bf2f(unsigned u16) { return __uint_as_float(u16 << 16); }
__device__ __forceinline__ float bflo(unsigned w) { return __uint_as_float(w << 16); }
__device__ __forceinline__ float bfhi(unsigned w) { return __uint_as_float(w & 0xffff0000u); }
__device__ __forceinline__ float wave_sum(float v) {
#pragma unroll
    for (int o = 1; o < 64; o <<= 1) v += __shfl_xor(v, o);
    return v;
}
__device__ __forceinline__ float fexp(float x) { return __builtin_amdgcn_exp2f(x * 1.4426950408889634f); }
__device__ __forceinline__ float flog(float x) { return __builtin_amdgcn_logf(x) * 0.6931471805599453f; }
__device__ __forceinline__ float silu_f(float g) { return g * __builtin_amdgcn_rcpf(1.f + __builtin_amdgcn_exp2f(g * -1.4426950408889634f)); }
__device__ __forceinline__ float row_rstd(const float* ssq, int row) {
    const f32x4 a = *(const f32x4*)(ssq + (size_t)row * 4);
    const float s = (a.x + a.y) + (a.z + a.w);
    return rsqrtf(s * (1.f / 1024.f) + EPS);
}

namespace pg8 {
constexpr int BM = 256, BK = 64, HALF = 128, HTB = HALF * BK * 2, STAGE_BYTES = 8 * HTB, NXCD = 8, WGM = 4;
__host__ __device__ __forceinline__ int lds_byte(int r, int c) { const int st = (r >> 4) * 2 + (c >> 5), rr = r & 15, cc = c & 31, ob = rr * 64 + cc * 2; return st * 1024 + (ob ^ (((ob >> 9) & 1) << 5)); }
__host__ __device__ __forceinline__ void stage_rc(int b, int& R, int& C) { const int st = b / 1024, sb = b % 1024, swz = sb ^ (((sb >> 9) & 1) << 5); R = (st >> 1) * 16 + swz / 64; C = (st & 1) * 32 + (swz % 64) / 2; }
__host__ __device__ __forceinline__ int perm32(int rho) { const int n = rho >> 4, i = rho & 15; return 8 * (i >> 2) + 4 * n + (i & 3); }

struct Unit { int pm, pn; };
struct Gemm { const bf16_t* A; const bf16_t* Bt; int K, lda, ldb, a_pn_off; };

struct StaticOrder {
    int nM, nN, nwg, G, c; bool rev = false;
    __host__ __device__ void init(int M, int N, int G_, int c_) { nM = M / BM; nN = N / BM; nwg = nM * nN; G = G_; c = c_; }
    __host__ __device__ bool next(int i, Unit& u) const {
        const int nr = (nwg + G - 1) / G; if (i >= nr) return false;
        const long L = (long)(rev ? nr - 1 - i : i) * G + c; if (L >= nwg) return false;
        int wgid = (int)L; { const int q = nwg / NXCD, r = nwg % NXCD, xcd = wgid % NXCD, off = wgid / NXCD; wgid = (xcd < r ? xcd * (q + 1) : r * (q + 1) + (xcd - r) * q) + off; }
        const int nig = WGM * nN, gid = wgid / nig, fm = gid * WGM, gsz = (nM - fm) < WGM ? (nM - fm) : WGM;
        u.pm = fm + ((wgid % nig) % gsz); u.pn = (wgid % nig) / gsz; return true;
    }
};


__device__ __forceinline__ const LAS float* rstd_panel(LAS unsigned char* lds, const float* ssq, int pm, int tid) {
    LAS float* RT = (LAS float*)(lds + STAGE_BYTES + 4096); volatile LAS int* TG = (volatile LAS int*)(lds + STAGE_BYTES + 8208);
    const int slot = (pm >> 3) & 3;
    asm volatile("s_waitcnt lgkmcnt(0)" ::: "memory"); __builtin_amdgcn_s_barrier(); asm volatile("" ::: "memory");
    if (TG[slot] != pm) {
        if (tid < 256) RT[slot * 256 + tid] = row_rstd(ssq, pm * BM + tid);
        asm volatile("s_waitcnt lgkmcnt(0)" ::: "memory"); __builtin_amdgcn_s_barrier(); asm volatile("" ::: "memory");
        if (tid == 0) TG[slot] = pm;
    }
    return RT + slot * 256;
}
struct EpiGU {
    static constexpr bool PERM = true;
    bf16_t* H; const float* ssq;
    __device__ __forceinline__ void operator()(const f32x4 (&acc)[2][2][4][2], const Unit& u, int wr, int wc, int fr, int fq, LAS unsigned char* lds, int tid) const {
        const int row0 = u.pm * BM + wr * 64 + fr, col0 = u.pn * 128 + wc * 32 + 8 * fq;
        const LAS float* RT = rstd_panel(lds, ssq, u.pm, tid);
#pragma unroll
        for (int ai = 0; ai < 2; ++ai) {
            float rs[4];
#pragma unroll
            for (int m = 0; m < 4; ++m) rs[m] = RT[wr * 64 + fr + ai * HALF + m * 16];
#pragma unroll
            for (int m = 0; m < 4; ++m) {
                const int row = row0 + ai * HALF + m * 16; const float r = rs[m];
                const f32x4 g0 = acc[ai][0][m][0] * r, g1 = acc[ai][0][m][1] * r, u0 = acc[ai][1][m][0] * r, u1 = acc[ai][1][m][1] * r;
                u32x4 w;
                w.x = pk2(silu_f(g0[0]) * u0[0], silu_f(g0[1]) * u0[1]); w.y = pk2(silu_f(g0[2]) * u0[2], silu_f(g0[3]) * u0[3]);
                w.z = pk2(silu_f(g1[0]) * u1[0], silu_f(g1[1]) * u1[1]); w.w = pk2(silu_f(g1[2]) * u1[2], silu_f(g1[3]) * u1[3]);
                *(u32x4*)(H + (size_t)row * DFF + col0) = w;
            }
        }
    }
};
struct EpiProj {
    static constexpr bool PERM = true;
    bf16_t* P; float* gbuf; const float* ssq;
    __device__ __forceinline__ void operator()(const f32x4 (&acc)[2][2][4][2], const Unit& u, int wr, int wc, int fr, int fq, LAS unsigned char* lds, int tid) const {
        const int row0 = u.pm * BM + wr * 64 + fr, col0 = u.pn * BM + wc * 32 + 8 * fq;
        const bool gate = (u.pn == 12) && (wc == 0);
        const LAS float* RT = rstd_panel(lds, ssq, u.pm, tid);
#pragma unroll
        for (int ai = 0; ai < 2; ++ai) {
            float rs[4];
#pragma unroll
            for (int m = 0; m < 4; ++m) rs[m] = RT[wr * 64 + fr + ai * HALF + m * 16];
#pragma unroll
            for (int m = 0; m < 4; ++m) {
                const int row = row0 + ai * HALF + m * 16; const float r = rs[m];
#pragma unroll
                for (int bj = 0; bj < 2; ++bj) {
                    const f32x4 v0 = acc[ai][bj][m][0] * r, v1 = acc[ai][bj][m][1] * r;
                    u32x4 w; w.x = pk2(v0[0], v0[1]); w.y = pk2(v0[2], v0[3]); w.z = pk2(v1[0], v1[1]); w.w = pk2(v1[2], v1[3]);
                    *(u32x4*)(P + (size_t)row * GINP + col0 + bj * HALF) = w;
                    if (bj == 0 && gate) { float* gp = gbuf + (size_t)row * 32 + 8 * fq; *(f32x4*)gp = v0; *(f32x4*)(gp + 4) = v1; }
                }
            }
        }
    }
};
struct EpiRes {
    static constexpr bool PERM = true;
    const bf16_t* xin; bf16_t* xb; float* ssq;
    __device__ __forceinline__ void operator()(const f32x4 (&acc)[2][2][4][2], const Unit& u, int wr, int wc, int fr, int fq, LAS unsigned char* lds, int tid) const {
        const int col0 = u.pn * BM + wc * 32 + 8 * fq;
        LAS float* RED = (LAS float*)(lds + STAGE_BYTES);
#pragma unroll
        for (int ai = 0; ai < 2; ++ai) {
            u32x4 bw[4][2];
#pragma unroll
            for (int m = 0; m < 4; ++m)
#pragma unroll
                for (int bj = 0; bj < 2; ++bj) bw[m][bj] = *(const u32x4*)(xin + (size_t)(u.pm * BM + ai * HALF + wr * 64 + m * 16 + fr) * DM + col0 + bj * HALF);
#pragma unroll
            for (int m = 0; m < 4; ++m) {
                const int rl = ai * HALF + wr * 64 + m * 16 + fr;
                bf16_t* xp = xb + (size_t)(u.pm * BM + rl) * DM + col0;
                float sq = 0.f;
#pragma unroll
                for (int bj = 0; bj < 2; ++bj) {
                    const u32x4 w0 = bw[m][bj];
                    const f32x4 o0 = (f32x4){bflo(w0.x), bfhi(w0.x), bflo(w0.y), bfhi(w0.y)} + acc[ai][bj][m][0];
                    const f32x4 o1 = (f32x4){bflo(w0.z), bfhi(w0.z), bflo(w0.w), bfhi(w0.w)} + acc[ai][bj][m][1];
                    sq += ((o0[0] * o0[0] + o0[1] * o0[1]) + (o0[2] * o0[2] + o0[3] * o0[3])) + ((o1[0] * o1[0] + o1[1] * o1[1]) + (o1[2] * o1[2] + o1[3] * o1[3]));
                    u32x4 w; w.x = pk2(o0[0], o0[1]); w.y = pk2(o0[2], o0[3]); w.z = pk2(o1[0], o1[1]); w.w = pk2(o1[2], o1[3]);
                    *(u32x4*)(xp + bj * HALF) = w;
                }
                sq += __shfl_xor(sq, 16); sq += __shfl_xor(sq, 32);
                if (fq == 0) RED[wc * 256 + rl] = sq;
            }
        }
        asm volatile("s_waitcnt lgkmcnt(0)" ::: "memory"); __builtin_amdgcn_s_barrier(); asm volatile("" ::: "memory");
        if (tid < 256) ssq[(size_t)(u.pm * BM + tid) * 4 + u.pn] = (RED[tid] + RED[256 + tid]) + (RED[512 + tid] + RED[768 + tid]);
    }
};

template <class Epi, class Sched>
__device__ __forceinline__ void gemm_phase(LAS unsigned char* lds, const Gemm g, const Sched& S, const Epi& E) {
    int tid = threadIdx.x; asm volatile("" : "+v"(tid));
    const int wid = __builtin_amdgcn_readfirstlane(tid >> 6), lane = tid & 63, wr = wid >> 2, wc = wid & 3, fr = lane & 15, fq = lane >> 4;
    const int K = g.K, nt = K / BK;
    unsigned voffA[2], voffB[2];
#pragma unroll
    for (int i = 0; i < 2; ++i) { int R, C; stage_rc(tid * 16 + i * 8192, R, C); const int Rb = Epi::PERM ? ((R & ~31) + perm32(R & 31)) : R;
        voffA[i] = (unsigned)(R * g.lda + C) * 2u; voffB[i] = (unsigned)(Rb * g.ldb + C) * 2u; }
    const size_t kstep = (size_t)(BK * 2);
    const size_t hstepA = (size_t)HALF * g.lda * 2, hstepB = (size_t)HALF * g.ldb * 2;
    const size_t tstepA = 2 * hstepA, tstepB = 2 * hstepB, apn = (size_t)g.a_pn_off * 2;
    const unsigned ldsw = (unsigned)wid * 1024u;
    const int aoff = lds_byte(wr * 64 + fr, fq * 8), boff = lds_byte(wc * 32 + fr, fq * 8);
#define PG8_SA(b, h) (((b) * 2 + (h)) * HTB)
#define PG8_SB(b, h) ((4 + (b) * 2 + (h)) * HTB)
#define PG8_STAGE(bufoff, gbase, voff) do { _Pragma("unroll") for (int _i = 0; _i < 2; ++_i) \
        __builtin_amdgcn_global_load_lds((const unsigned*)((const char*)(gbase) + (voff)[_i]), (LAS unsigned*)(lds + (bufoff) + ldsw + _i * 8192), 16, 0, 0); } while (0)
#define PG8_LDA(dst, b, h) do { _Pragma("unroll") for (int m = 0; m < 4; ++m) _Pragma("unroll") for (int k = 0; k < 2; ++k) dst[m][k] = *(const LAS bf16x8*)(lds + PG8_SA(b, h) + aoff + m * 2048 + k * 1024); } while (0)
#define PG8_LDB(dst, b, h) do { _Pragma("unroll") for (int n = 0; n < 2; ++n) _Pragma("unroll") for (int k = 0; k < 2; ++k) dst[n][k] = *(const LAS bf16x8*)(lds + PG8_SB(b, h) + boff + n * 2048 + k * 1024); } while (0)
#define PG8_MMA(ai, bj, At, Bt) do { __builtin_amdgcn_s_setprio(1); _Pragma("unroll") for (int m = 0; m < 4; ++m) _Pragma("unroll") for (int n = 0; n < 2; ++n) _Pragma("unroll") for (int k = 0; k < 2; ++k) \
        acc[ai][bj][m][n] = __builtin_amdgcn_mfma_f32_16x16x32_bf16(Bt[n][k], At[m][k], acc[ai][bj][m][n], 0, 0, 0); __builtin_amdgcn_s_setprio(0); } while (0)
#define PG8_WAIT_V(n) asm volatile("s_waitcnt vmcnt(" #n ")" ::: "memory")
#define PG8_WAIT_L(n) asm volatile("s_waitcnt lgkmcnt(" #n ")" ::: "memory")
#define PG8_BAR __builtin_amdgcn_s_barrier()
#define PG8_SCHED __builtin_amdgcn_sched_barrier(0)
    Unit cur, nxt; int ui = 0;
    if (!S.next(0, cur)) return;
    f32x4 acc[2][2][4][2];
#pragma unroll
    for (int a = 0; a < 2; ++a)
#pragma unroll
        for (int b = 0; b < 2; ++b)
#pragma unroll
            for (int m = 0; m < 4; ++m)
#pragma unroll
                for (int n = 0; n < 2; ++n) acc[a][b][m][n] = (f32x4){0.f, 0.f, 0.f, 0.f};
    bf16x8 At[4][2], B0[2][2], B1[2][2];
    const char* cA = (const char*)g.A + (size_t)cur.pm * tstepA + (size_t)cur.pn * apn; const char* cB = (const char*)g.Bt + (size_t)cur.pn * tstepB;
    PG8_STAGE(PG8_SB(0, 0), cB, voffB); PG8_STAGE(PG8_SB(0, 1), cB + hstepB, voffB); PG8_STAGE(PG8_SA(0, 0), cA, voffA); PG8_STAGE(PG8_SA(0, 1), cA + hstepA, voffA);
    if (wr == 1) PG8_BAR;
    PG8_WAIT_V(2); PG8_BAR;
    PG8_STAGE(PG8_SB(1, 0), cB + kstep, voffB); PG8_STAGE(PG8_SA(1, 0), cA + kstep, voffA); PG8_STAGE(PG8_SB(1, 1), cB + hstepB + kstep, voffB);
    PG8_WAIT_V(6); PG8_BAR;
    for (;;) {
        const bool has_next = S.next(ui + 1, nxt);
        const char* nA = has_next ? (const char*)g.A + (size_t)nxt.pm * tstepA + (size_t)nxt.pn * apn : cA; const char* nB = has_next ? (const char*)g.Bt + (size_t)nxt.pn * tstepB : cB;
        for (int t = 0; t < nt; t += 2) {
            const bool last = (t == nt - 2);
            const char* a1 = cA + (size_t)(t + 1) * kstep;
            const char* a2 = last ? nA : cA + (size_t)(t + 2) * kstep; const char* b2 = last ? nB : cB + (size_t)(t + 2) * kstep;
            const char* a3 = a2 + kstep; const char* b3 = b2 + kstep;
            PG8_LDB(B0, 0, 0); PG8_LDB(B1, 0, 1); PG8_SCHED; PG8_LDA(At, 0, 0); PG8_STAGE(PG8_SA(1, 1), a1 + hstepA, voffA);
            PG8_WAIT_V(8); PG8_WAIT_L(0); PG8_BAR; PG8_MMA(0, 0, At, B0); PG8_MMA(0, 1, At, B1); PG8_BAR; PG8_SCHED;
            PG8_LDA(At, 0, 1); PG8_STAGE(PG8_SB(0, 0), b2, voffB); PG8_STAGE(PG8_SB(0, 1), b2 + hstepB, voffB); PG8_STAGE(PG8_SA(0, 0), a2, voffA);
            PG8_WAIT_V(8); PG8_WAIT_L(0); PG8_BAR; PG8_MMA(1, 0, At, B0); PG8_MMA(1, 1, At, B1); PG8_BAR; PG8_SCHED;
            PG8_LDB(B0, 1, 0); PG8_LDB(B1, 1, 1); PG8_SCHED; PG8_LDA(At, 1, 0); PG8_STAGE(PG8_SA(0, 1), a2 + hstepA, voffA);
            PG8_WAIT_V(8); PG8_WAIT_L(0); PG8_BAR; PG8_MMA(0, 0, At, B0); PG8_MMA(0, 1, At, B1); PG8_BAR; PG8_SCHED;
            PG8_LDA(At, 1, 1); PG8_STAGE(PG8_SB(1, 0), b3, voffB); PG8_STAGE(PG8_SB(1, 1), b3 + hstepB, voffB); PG8_STAGE(PG8_SA(1, 0), a3, voffA);
            PG8_WAIT_V(8); PG8_WAIT_L(0); PG8_BAR; PG8_MMA(1, 0, At, B0); PG8_MMA(1, 1, At, B1); PG8_BAR; PG8_SCHED;
        }
        if (wr == 0) PG8_BAR;
        E(acc, cur, wr, wc, fr, fq, lds, tid);
        if (!has_next) break;
#pragma unroll
        for (int a = 0; a < 2; ++a)
#pragma unroll
            for (int b = 0; b < 2; ++b)
#pragma unroll
                for (int m = 0; m < 4; ++m)
#pragma unroll
                    for (int n = 0; n < 2; ++n) acc[a][b][m][n] = (f32x4){0.f, 0.f, 0.f, 0.f};
        cur = nxt; cA = nA; cB = nB; ++ui;
        if (wr == 1) PG8_BAR;
    }
    PG8_WAIT_V(0);
    PG8_BAR;
#undef PG8_SA
#undef PG8_SB
#undef PG8_STAGE
#undef PG8_LDA
#undef PG8_LDB
#undef PG8_MMA
#undef PG8_WAIT_V
#undef PG8_WAIT_L
#undef PG8_BAR
#undef PG8_SCHED
}
}

struct Params {
    const float* x; const float* norm_mix; const float* norm_ffn; const float* norm_final;
    const float* w_pool; const float* pool_scale; const float* w_gla_in; const float* w_gate_up; const float* b_gate;
    const float* gla_head_norm; const float* w_gla_out; const float* w_ffn_gate; const float* w_ffn_up; const float* w_ffn_down;
    float* out; unsigned char* ws;
};

struct P0Item { const float* W; bf16_t* WT; const float* kscale; const float* nscale; int N, ldt, k0, n0, drow0; float cscale; };
__device__ __forceinline__ P0Item p0_decode(const Params& p, int it) {
    constexpr int I_G = (DM / 64) * (DFF / 32), I_D = (DFF / 64) * (DM / 32), I_L = 2 * I_G + I_D;
    constexpr int I_IN = (DM / 64) * (GIN / 32), I_OUT = (DM / 64) * (DM / 32), I_J = I_IN + I_OUT;
    constexpr int I_P = (256 / 64) * (256 / 32);
    unsigned char* ws = p.ws; P0Item q; int r = it;
    if (r < 4 * I_L) {
        const int l = r / I_L; r -= l * I_L;
        if (r < 2 * I_G) {
            const int up = r / I_G; r -= up * I_G;
            const int nb = r % (DFF / 32), kb = r / (DFF / 32), n0 = nb * 32;
            q.W = (up ? p.w_ffn_up : p.w_ffn_gate) + (size_t)l * DM * DFF; q.N = DFF; q.WT = (bf16_t*)(ws + WS_WGU + l * SZ_WGU); q.ldt = DM; q.k0 = kb * 64; q.n0 = n0;
            q.drow0 = (n0 >> 7) * 256 + up * 128 + (n0 & 127); q.kscale = p.norm_ffn + l * DM; q.nscale = nullptr; q.cscale = 1.f;
        } else {
            r -= 2 * I_G;
            const int nb = r % (DM / 32), kb = r / (DM / 32), n0 = nb * 32;
            q.W = p.w_ffn_down + (size_t)l * DFF * DM; q.N = DM; q.WT = (bf16_t*)(ws + WS_WD + l * SZ_WD); q.ldt = DFF; q.k0 = kb * 64; q.n0 = n0; q.drow0 = n0; q.kscale = nullptr; q.nscale = nullptr; q.cscale = 1.f;
        }
        return q;
    }
    r -= 4 * I_L;
    if (r < 2 * I_J) {
        const int j = r / I_J; r -= j * I_J;
        if (r < I_IN) {
            const int nb = r % (GIN / 32), kb = r / (GIN / 32), n0 = nb * 32;
            q.W = p.w_gla_in + (size_t)j * DM * GIN; q.N = GIN; q.WT = (bf16_t*)(ws + WS_WIN + j * SZ_WIN); q.ldt = DM; q.k0 = kb * 64; q.n0 = n0; q.drow0 = n0;
            q.kscale = p.norm_mix + (2 * j + 1) * DM; q.nscale = nullptr; q.cscale = n0 < 512 ? 0.08838834764831845f : 1.f;
        } else {
            r -= I_IN;
            const int nb = r % (DM / 32), kb = r / (DM / 32), n0 = nb * 32;
            q.W = p.w_gla_out + (size_t)j * DM * DM; q.N = DM; q.WT = (bf16_t*)(ws + WS_WOUT + j * SZ_WOUT); q.ldt = DM; q.k0 = kb * 64; q.n0 = n0; q.drow0 = n0; q.kscale = nullptr; q.nscale = nullptr; q.cscale = 1.f;
        }
        return q;
    }
    r -= 2 * I_J;
    {
        const int jg = r / I_P; r -= jg * I_P; const int j = jg >> 2, g = jg & 3;
        const int nb = r % 8, kb = r / 8, n0 = nb * 32;
        q.W = p.w_pool + (size_t)jg * 256 * 256; q.N = 256; q.WT = (bf16_t*)(ws + WS_WPOOL + j * SZ_WPOOL); q.ldt = 256; q.k0 = kb * 64; q.n0 = n0; q.drow0 = g * 256 + n0;
        q.kscale = nullptr; q.nscale = p.pool_scale + j * DM + g * 256; q.cscale = 1.f;
    }
    return q;
}
__device__ __forceinline__ void p0_load(const P0Item& q, int lane, float (&v)[32]) {
#pragma unroll
    for (int i = 0; i < 32; ++i) { const int kk = 2 * i + (lane >> 5); v[i] = q.W[(size_t)(q.k0 + kk) * q.N + q.n0 + (lane & 31)]; }
}
__device__ __forceinline__ void p0_finish(const P0Item& q, LAS float* scr, int lane, const float (&v)[32]) {
#pragma unroll
    for (int i = 0; i < 32; ++i) { const int kk = 2 * i + (lane >> 5); scr[kk * 33 + (lane & 31)] = v[i]; }
    asm volatile("s_waitcnt lgkmcnt(0)" ::: "memory");
    const int c = lane & 7;
    f32x4 ka = (f32x4){1.f, 1.f, 1.f, 1.f}, kb = ka;
    if (q.kscale) { ka = *(const f32x4*)(q.kscale + q.k0 + 8 * c); kb = *(const f32x4*)(q.kscale + q.k0 + 8 * c + 4); }
#pragma unroll
    for (int j = 0; j < 4; ++j) { const int n = (lane >> 3) + 8 * j; const LAS float* s = scr + (8 * c) * 33 + n;
        const float ns = (q.nscale ? q.nscale[q.n0 + n] : 1.f) * q.cscale;
        u32x4 o; o.x = pk2(s[0 * 33] * ka[0] * ns, s[1 * 33] * ka[1] * ns); o.y = pk2(s[2 * 33] * ka[2] * ns, s[3 * 33] * ka[3] * ns);
        o.z = pk2(s[4 * 33] * kb[0] * ns, s[5 * 33] * kb[1] * ns); o.w = pk2(s[6 * 33] * kb[2] * ns, s[7 * 33] * kb[3] * ns);
        *(u32x4*)(q.WT + (size_t)(q.drow0 + n) * q.ldt + q.k0 + 8 * c) = o; }
    asm volatile("s_waitcnt lgkmcnt(0)" ::: "memory");
}

__device__ __forceinline__ void p0_phase(const Params& p, LAS unsigned char* lds) {
    int tid = threadIdx.x; asm volatile("" : "+v"(tid));
    const int lane = tid & 63, wave = __builtin_amdgcn_readfirstlane(tid >> 6);
    LAS float* scr = (LAS float*)(lds + wave * 16384);
    const int gw = blockIdx.x * NWAVES + wave, NGW = gridDim.x * NWAVES;
    constexpr int NITEMS = 4 * (2 * (DM / 64) * (DFF / 32) + (DFF / 64) * (DM / 32)) + 2 * ((DM / 64) * (GIN / 32) + (DM / 64) * (DM / 32)) + 8 * (256 / 64) * (256 / 32);
    unsigned char* ws = p.ws;
    if (gw < NITEMS) {
        P0Item cur = p0_decode(p, gw); float v[32]; p0_load(cur, lane, v);
        for (int it = gw; it < NITEMS; it += NGW) {
            const int nit = it + NGW < NITEMS ? it + NGW : it;
            const P0Item nxt = p0_decode(p, nit); float vn[32]; p0_load(nxt, lane, vn);
            p0_finish(cur, scr, lane, v);
            cur = nxt;
#pragma unroll
            for (int i = 0; i < 32; ++i) v[i] = vn[i];
        }
    }
    for (int e = gw * 64 + lane; e < 2 * (GINP - GIN) * DM / 8; e += NGW * 64) {
        const int j = e / ((GINP - GIN) * DM / 8), q = e % ((GINP - GIN) * DM / 8);
        *(u32x4*)(ws + WS_WIN + j * SZ_WIN + (size_t)GIN * DM * 2 + (size_t)q * 16) = (u32x4){0u, 0u, 0u, 0u};
    }
    float* ssq = (float*)(ws + WS_SSQ);
    {
        f32x4 v[4], nv[4];
#define P0_LOAD(V_, row_) do { const f32x4* xr_ = (const f32x4*)(p.x + (size_t)(row_) * DM) + lane; _Pragma("unroll") for (int j = 0; j < 4; ++j) V_[j] = xr_[64 * j]; } while (0)
        if (gw < MTOK) P0_LOAD(v, gw);
        if (gw + NGW < MTOK) P0_LOAD(nv, gw + NGW);
        for (int row = gw; row < MTOK; row += NGW) {
            f32x4 c[4];
#pragma unroll
            for (int j = 0; j < 4; ++j) { c[j] = v[j]; v[j] = nv[j]; }
            if (row + 2 * NGW < MTOK) P0_LOAD(nv, row + 2 * NGW);
            float s = 0.f;
            u32x2* xo = (u32x2*)(ws + WS_XB + (size_t)row * DM * 2) + lane;
#pragma unroll
            for (int j = 0; j < 4; ++j) { s += (c[j].x * c[j].x + c[j].y * c[j].y) + (c[j].z * c[j].z + c[j].w * c[j].w); u32x2 w; w.x = pk2(c[j].x, c[j].y); w.y = pk2(c[j].z, c[j].w); xo[64 * j] = w; }
            s = wave_sum(s);
            if (lane < 4) ssq[(size_t)row * 4 + lane] = lane == 0 ? s : 0.f;
        }
#undef P0_LOAD
    }
}

__device__ __forceinline__ void pool_prep_phase(LAS unsigned char* lds, const bf16_t* x, const float* ssq, const float* gain, bf16_t* mixed) {
    int tid = threadIdx.x; asm volatile("" : "+v"(tid));
    LAS float* HT = (LAS float*)lds; LAS float* RS = (LAS float*)(lds + 81920);
    const int nitems = MTOK / 64;
    const int nit = (int)blockIdx.x < nitems ? (nitems - (int)blockIdx.x + (int)gridDim.x - 1) / (int)gridDim.x : 0;
    const int nsteps = nit * 4;
    u32x2 raw[10];
#define PP_GEO(st_) const int g_ = (st_) & 3, tok0_ = ((int)blockIdx.x + ((st_) >> 2) * (int)gridDim.x) * 64, s0_ = tok0_ & (SEQ - 1); \
        const int win_ = 2 << g_, left_ = win_ >> 1, right_ = win_ - 1 - left_, rlo_ = 8 - left_, nrows_ = 64 + left_ + right_;
#define PP_LOAD(st_) do { PP_GEO(st_) _Pragma("unroll") for (int k = 0; k < 10; ++k) { const int e = tid + k * NTHREADS; raw[k] = (u32x2){0u, 0u}; \
        if (e < nrows_ * 64) { const int rr = rlo_ + (e >> 6), c4 = e & 63, pos = s0_ - 8 + rr; \
            if (pos >= 0 && pos < SEQ) raw[k] = *(const u32x2*)(x + (size_t)(tok0_ - 8 + rr) * DM + g_ * 256 + c4 * 4); } } } while (0)
    if (nsteps > 0) PP_LOAD(0);
    for (int st = 0; st < nsteps; ++st) {
        PP_GEO(st)
        if (g_ == 0) {
            if (tid < 79) { const int pos = s0_ - 8 + tid; float r = 0.f; if (pos >= 0 && pos < SEQ) r = row_rstd(ssq, tok0_ - 8 + tid); RS[tid] = r; }
            __syncthreads();
        }
#pragma unroll
        for (int k = 0; k < 10; ++k) {
            const int e = tid + k * NTHREADS;
            if (e < nrows_ * 64) { const int rr = rlo_ + (e >> 6), c4 = e & 63; const u32x2 w = raw[k];
                *(LAS f32x4*)(HT + rr * 256 + c4 * 4) = (f32x4){bflo(w.x), bfhi(w.x), bflo(w.y), bfhi(w.y)} * RS[rr]; }
        }
        __syncthreads();
        if (st + 1 < nsteps) PP_LOAD(st + 1);
        {
            const int cq = tid & 63, tq = tid >> 6;
            const f32x4 gn = *(const f32x4*)(gain + g_ * 256 + cq * 4);
            const int tl0 = tq * 8;
            f32x4 sum = (f32x4){0.f, 0.f, 0.f, 0.f};
            for (int q = -left_; q <= right_; ++q) sum += *(const LAS f32x4*)(HT + (tl0 + 8 + q) * 256 + cq * 4);
#pragma unroll
            for (int tt = 0; tt < 8; ++tt) {
                const int tl = tl0 + tt, pos = s0_ + tl;
                const int lo = (pos - left_) > 0 ? (pos - left_) : 0, hi = (pos + right_ + 1) < SEQ ? (pos + right_ + 1) : SEQ;
                const f32x4 self = *(const LAS f32x4*)(HT + (tl + 8) * 256 + cq * 4);
                const f32x4 o = (sum * __builtin_amdgcn_rcpf((float)(hi - lo)) - self) * gn;
                u32x2 w; w.x = pk2(o[0], o[1]); w.y = pk2(o[2], o[3]);
                *(u32x2*)(mixed + (size_t)(tok0_ + tl) * DM + g_ * 256 + cq * 4) = w;
                if (tt < 7) { sum += *(const LAS f32x4*)(HT + (tl + 8 + right_ + 1) * 256 + cq * 4); sum -= *(const LAS f32x4*)(HT + (tl + 8 - left_) * 256 + cq * 4); }
            }
        }
        __syncthreads();
    }
#undef PP_LOAD
#undef PP_GEO
}

constexpr int GL_QD = 0, GL_KI = 17408, GL_KDT = 34816, GL_VT = 53248, GL_SC = 90112, GL_Z = 99328  , GL_SEG = 132096, GL_EBL = 134144;
#define MFMA32(a, b, c) __builtin_amdgcn_mfma_f32_32x32x16_bf16((a), (b), (c), 0, 0, 0)
#define MFMA16(a, b, c) __builtin_amdgcn_mfma_f32_16x16x32_bf16((a), (b), (c), 0, 0, 0)
__device__ __forceinline__ void gla_scan_phase(LAS unsigned char* lds, const bf16_t* proj, const float* gbuf, const float* wgu  , const float* bg  ,
                                               bf16_t* ob0, bf16_t* ob1) {
    int tid = threadIdx.x; asm volatile("" : "+v"(tid));
    const int lane = tid & 63, wave = __builtin_amdgcn_readfirstlane(tid >> 6);
    const int d = tid & 127, seg = tid >> 7;
    const int r = lane & 31, hh = lane >> 5, fr = lane & 15, fq = lane >> 4;
    for (int item = blockIdx.x; item < BATCH * 8; item += gridDim.x) {
        const int b = item >> 3, h = (item >> 1) & 3, dir = item & 1;
        bf16_t* ob = dir ? ob1 : ob0;
        const int zt = wave >> 2, zd = wave & 3;
        bf16x8 wbh, wbl;
        {
            unsigned hi_[4], lo_[4];
#pragma unroll
            for (int q = 0; q < 4; ++q) {
                const float w0 = wgu[(size_t)(dir * 16 + 8 * hh + 2 * q) * 512 + h * 128 + 32 * zd + r], w1 = wgu[(size_t)(dir * 16 + 8 * hh + 2 * q + 1) * 512 + h * 128 + 32 * zd + r];
                hi_[q] = pk2(w0, w1); lo_[q] = pk2(w0 - bflo(hi_[q]), w1 - bfhi(hi_[q]));
            }
            wbh = __builtin_bit_cast(bf16x8, (u32x4){hi_[0], hi_[1], hi_[2], hi_[3]}); wbl = __builtin_bit_cast(bf16x8, (u32x4){lo_[0], lo_[1], lo_[2], lo_[3]});
        }
        const float zbias = bg[dir * 512 + h * 128 + 32 * zd + r];
        f32x16 S[4];
#pragma unroll
        for (int kt = 0; kt < 4; ++kt)
#pragma unroll
            for (int i = 0; i < 16; ++i) S[kt][i] = 0.f;
        f32x4 gna, gnb;
        { const float* grow = gbuf + (size_t)(b * SEQ + (dir ? SEQ / 64 - 1 : 0) * 64 + 32 * zt + r) * 32 + dir * 16 + 8 * hh; gna = *(const f32x4*)grow; gnb = *(const f32x4*)(grow + 4); }
        for (int n = 0; n < SEQ / 64; ++n) {
            const int c = dir ? (SEQ / 64 - 1 - n) : n;
            const int tok0 = b * SEQ + c * 64;
            const f32x4 ga = gna, gb = gnb;
            const bf16_t* prow = proj + (size_t)(tok0 + 16 * seg) * GINP + h * 128 + d;
            unsigned short qv[16], kv[16];
#pragma unroll
            for (int ii = 0; ii < 16; ++ii) { qv[ii] = prow[(size_t)ii * GINP]; kv[ii] = prow[(size_t)ii * GINP + 512]; }
            const bf16_t* vrow = proj + (size_t)(tok0 + 16 * seg) * GINP + 1024 + h * 256 + 2 * d;
            unsigned vw[16];
#pragma unroll
            for (int ii = 0; ii < 16; ++ii) vw[ii] = *(const unsigned*)(vrow + (size_t)ii * GINP);
            {
                u32x4 ah, al;
                ah.x = pk2(ga[0], ga[1]); ah.y = pk2(ga[2], ga[3]); ah.z = pk2(gb[0], gb[1]); ah.w = pk2(gb[2], gb[3]);
                al.x = pk2(ga[0] - bflo(ah.x), ga[1] - bfhi(ah.x)); al.y = pk2(ga[2] - bflo(ah.y), ga[3] - bfhi(ah.y));
                al.z = pk2(gb[0] - bflo(ah.z), gb[1] - bfhi(ah.z)); al.w = pk2(gb[2] - bflo(ah.w), gb[3] - bfhi(ah.w));
                const bf16x8 gah = __builtin_bit_cast(bf16x8, ah), gal = __builtin_bit_cast(bf16x8, al);
                f32x16 zacc;
#pragma unroll
                for (int i = 0; i < 16; ++i) zacc[i] = zbias;
                zacc = MFMA32(gah, wbh, zacc); zacc = MFMA32(gal, wbh, zacc); zacc = MFMA32(gah, wbl, zacc);
#pragma unroll
                for (int i = 0; i < 16; ++i) *(LAS float*)(lds + GL_Z + ((32 * zt + (i & 3) + 8 * (i >> 2) + 4 * hh) * 128 + 32 * zd + r) * 4) = zacc[i];
            }
            __syncthreads();
            float cs[16];
#pragma unroll
            for (int ii = 0; ii < 16; ++ii) {
                const float z = *(const LAS float*)(lds + GL_Z + ((16 * seg + ii) * 128 + d) * 4);
                cs[ii] = fminf(z, 0.f) * (1.4426950408889634f / 16.f) - __builtin_amdgcn_logf(1.f + __builtin_amdgcn_exp2f(fabsf(z) * -1.4426950408889634f)) * (1.f / 16.f);
            }
            if (dir == 0) {
#pragma unroll
                for (int ii = 1; ii < 16; ++ii) cs[ii] += cs[ii - 1];
                *(LAS float*)(lds + GL_SEG + (seg * 128 + d) * 4) = cs[15];
            } else {
#pragma unroll
                for (int ii = 14; ii >= 0; --ii) cs[ii] += cs[ii + 1];
                *(LAS float*)(lds + GL_SEG + (seg * 128 + d) * 4) = cs[0];
            }
            __syncthreads();
            const float t0 = *(const LAS float*)(lds + GL_SEG + (0 * 128 + d) * 4), t1 = *(const LAS float*)(lds + GL_SEG + (1 * 128 + d) * 4),
                        t2 = *(const LAS float*)(lds + GL_SEG + (2 * 128 + d) * 4), t3 = *(const LAS float*)(lds + GL_SEG + (3 * 128 + d) * 4);
            const float prefix = dir == 0 ? ((seg > 0 ? t0 : 0.f) + (seg > 1 ? t1 : 0.f) + (seg > 2 ? t2 : 0.f))
                                          : ((seg < 1 ? t1 : 0.f) + (seg < 2 ? t2 : 0.f) + (seg < 3 ? t3 : 0.f));
            const float ebl = __builtin_amdgcn_exp2f((t0 + t1) + (t2 + t3));
            unsigned kd[8];
#pragma unroll
            for (int ii = 0; ii < 16; ii += 2) {
                const float e0 = __builtin_amdgcn_exp2f(prefix + cs[ii]), e1 = __builtin_amdgcn_exp2f(prefix + cs[ii + 1]);
                const float q0 = bf2f(qv[ii]), q1 = bf2f(qv[ii + 1]);
                const float k0 = bf2f(kv[ii]) * __builtin_amdgcn_rcpf(e0), k1 = bf2f(kv[ii + 1]) * __builtin_amdgcn_rcpf(e1);
                const unsigned qd = pk2(q0 * e0, q1 * e1);
                const unsigned ki = pk2(k0, k1);
                kd[ii >> 1] = pk2(k0 * ebl, k1 * ebl);
                const int i0 = 16 * seg + ii;
                *(LAS unsigned short*)(lds + GL_QD + i0 * 272 + d * 2) = (unsigned short)(qd & 0xffffu);
                *(LAS unsigned short*)(lds + GL_QD + (i0 + 1) * 272 + d * 2) = (unsigned short)(qd >> 16);
                *(LAS unsigned short*)(lds + GL_KI + i0 * 272 + d * 2) = (unsigned short)(ki & 0xffffu);
                *(LAS unsigned short*)(lds + GL_KI + (i0 + 1) * 272 + d * 2) = (unsigned short)(ki >> 16);
            }
            *(LAS u32x4*)(lds + GL_KDT + d * 144 + seg * 32) = (u32x4){kd[0], kd[1], kd[2], kd[3]};
            *(LAS u32x4*)(lds + GL_KDT + d * 144 + seg * 32 + 16) = (u32x4){kd[4], kd[5], kd[6], kd[7]};
            if (seg == 0) *(LAS float*)(lds + GL_EBL + d * 4) = ebl;
            {
                unsigned c0[8], c1[8];
#pragma unroll
                for (int t = 0; t < 8; ++t) { const unsigned a_ = vw[2 * t], b_ = vw[2 * t + 1]; c0[t] = (a_ & 0xffffu) | (b_ << 16); c1[t] = (a_ >> 16) | (b_ & 0xffff0000u); }
                *(LAS u32x4*)(lds + GL_VT + (2 * d) * 144 + seg * 32) = (u32x4){c0[0], c0[1], c0[2], c0[3]};
                *(LAS u32x4*)(lds + GL_VT + (2 * d) * 144 + seg * 32 + 16) = (u32x4){c0[4], c0[5], c0[6], c0[7]};
                *(LAS u32x4*)(lds + GL_VT + (2 * d + 1) * 144 + seg * 32) = (u32x4){c1[0], c1[1], c1[2], c1[3]};
                *(LAS u32x4*)(lds + GL_VT + (2 * d + 1) * 144 + seg * 32 + 16) = (u32x4){c1[4], c1[5], c1[6], c1[7]};
            }
            __syncthreads();
            {
                const int ti = wave >> 1;
#pragma unroll
                for (int tjj = 0; tjj < 2; ++tjj) {
                    const int tj = 2 * (wave & 1) + tjj;
                    f32x4 a4 = (f32x4){0.f, 0.f, 0.f, 0.f};
#pragma unroll
                    for (int ks = 0; ks < 4; ++ks) {
                        const bf16x8 ka = *(const LAS bf16x8*)(lds + GL_KI + (16 * tj + fr) * 272 + ks * 64 + fq * 16);
                        const bf16x8 qb = *(const LAS bf16x8*)(lds + GL_QD + (16 * ti + fr) * 272 + ks * 64 + fq * 16);
                        a4 = MFMA16(ka, qb, a4);
                    }
                    const int qi = 16 * ti + fr, kj = 16 * tj + 4 * fq;
                    float m[4];
#pragma unroll
                    for (int e = 0; e < 4; ++e) { const bool keep = dir ? (kj + e > qi) : (kj + e <= qi); m[e] = keep ? a4[e] : 0.f; }
                    u32x2 w; w.x = pk2(m[0], m[1]); w.y = pk2(m[2], m[3]);
                    *(LAS u32x2*)(lds + GL_SC + qi * 144 + kj * 2) = w;
                }
            }
            __syncthreads();
            { const int n1 = n + 1 < SEQ / 64 ? n + 1 : n; const float* grow = gbuf + (size_t)(b * SEQ + (dir ? SEQ / 64 - 1 - n1 : n1) * 64 + 32 * zt + r) * 32 + dir * 16 + 8 * hh;
              gna = *(const f32x4*)grow; gnb = *(const f32x4*)(grow + 4); }
            bf16x8 bv[4];
#pragma unroll
            for (int ks = 0; ks < 4; ++ks) bv[ks] = *(const LAS bf16x8*)(lds + GL_VT + (32 * wave + r) * 144 + ks * 32 + hh * 16);
            f32x16 oacc[2];
#pragma unroll
            for (int mt = 0; mt < 2; ++mt) {
#pragma unroll
                for (int i = 0; i < 16; ++i) oacc[mt][i] = 0.f;
#pragma unroll
                for (int ks = 0; ks < 4; ++ks) {
                    const bf16x8 a = *(const LAS bf16x8*)(lds + GL_SC + (32 * mt + r) * 144 + ks * 32 + hh * 16);
                    oacc[mt] = MFMA32(a, bv[ks], oacc[mt]);
                }
            }
#pragma unroll
            for (int kt = 0; kt < 4; ++kt)
#pragma unroll
                for (int s = 0; s < 2; ++s) {
                    u32x4 sp;
                    sp.x = pk2(S[kt][8 * s + 0], S[kt][8 * s + 1]); sp.y = pk2(S[kt][8 * s + 2], S[kt][8 * s + 3]);
                    sp.z = pk2(S[kt][8 * s + 4], S[kt][8 * s + 5]); sp.w = pk2(S[kt][8 * s + 6], S[kt][8 * s + 7]);
                    const bf16x8 sb = __builtin_bit_cast(bf16x8, sp);
#pragma unroll
                    for (int mt = 0; mt < 2; ++mt) {
                        const s16x4 lo = *(const LAS s16x4*)(lds + GL_QD + (32 * mt + r) * 272 + kt * 64 + s * 32 + hh * 8);
                        const s16x4 hi = *(const LAS s16x4*)(lds + GL_QD + (32 * mt + r) * 272 + kt * 64 + s * 32 + hh * 8 + 16);
                        const bf16x8 a = __builtin_shufflevector(lo, hi, 0, 1, 2, 3, 4, 5, 6, 7);
                        oacc[mt] = MFMA32(a, sb, oacc[mt]);
                    }
                }
            {
                bf16_t* obase = ob + (size_t)(tok0 + 4 * hh) * DM + h * 256 + 32 * wave + r;
#pragma unroll
                for (int mt = 0; mt < 2; ++mt)
#pragma unroll
                    for (int i = 0; i < 16; ++i) {
                        const int row = 32 * mt + (i & 3) + 8 * (i >> 2);
                        obase[(size_t)row * DM] = (bf16_t)(pk2(oacc[mt][i], 0.f) & 0xffffu);
                    }
            }
#pragma unroll
            for (int kt = 0; kt < 4; ++kt) {
#pragma unroll
                for (int g4 = 0; g4 < 4; ++g4) {
                    const f32x4 e4 = *(const LAS f32x4*)(lds + GL_EBL + (32 * kt + 8 * g4 + 4 * hh) * 4);
#pragma unroll
                    for (int e = 0; e < 4; ++e) S[kt][4 * g4 + e] *= e4[e];
                }
#pragma unroll
                for (int ks = 0; ks < 4; ++ks) {
                    const bf16x8 a = *(const LAS bf16x8*)(lds + GL_KDT + (32 * kt + r) * 144 + ks * 32 + hh * 16);
                    S[kt] = MFMA32(a, bv[ks], S[kt]);
                }
            }
        }
        __syncthreads();
    }
}

constexpr int G2_SET = 43008, G2_QD = 0, G2_KDT = 8704, G2_VT = 18944, G2_SC = 39424, G2_EBL = 41984;
constexpr int G2_KI = 2 * G2_SET, G2_Z = G2_KI + 8704, G2_SEG = G2_Z + 16384;
#define G2_BAR() do { asm volatile("s_waitcnt lgkmcnt(0)" ::: "memory"); __builtin_amdgcn_s_barrier(); asm volatile("" ::: "memory"); } while (0)
__device__ __forceinline__ void gla_scan_phase2(LAS unsigned char* lds, const bf16_t* proj, const float* gbuf, const float* wgu  , const float* bg  ,
                                                bf16_t* ob0, bf16_t* ob1) {
    int tid = threadIdx.x; asm volatile("" : "+v"(tid));
    const int lane = tid & 63, wave = __builtin_amdgcn_readfirstlane(tid >> 6);
    const int r = lane & 31, hh = lane >> 5, fr = lane & 15, fq = lane >> 4;
    constexpr int CH = 32, NCH = SEQ / CH;
    for (int item = blockIdx.x; item < BATCH * 8; item += gridDim.x) {
        const int b = item >> 3, h = (item >> 1) & 3, dir = item & 1;
        if (wave < 4) {
            const int d = tid & 127, seg = (tid >> 7) & 1;
            const int zd = wave;
            bf16x8 wbh, wbl;
            {
                unsigned hi_[4], lo_[4];
#pragma unroll
                for (int q = 0; q < 4; ++q) {
                    const float w0 = wgu[(size_t)(dir * 16 + 8 * hh + 2 * q) * 512 + h * 128 + 32 * zd + r], w1 = wgu[(size_t)(dir * 16 + 8 * hh + 2 * q + 1) * 512 + h * 128 + 32 * zd + r];
                    hi_[q] = pk2(w0, w1); lo_[q] = pk2(w0 - bflo(hi_[q]), w1 - bfhi(hi_[q]));
                }
                wbh = __builtin_bit_cast(bf16x8, (u32x4){hi_[0], hi_[1], hi_[2], hi_[3]}); wbl = __builtin_bit_cast(bf16x8, (u32x4){lo_[0], lo_[1], lo_[2], lo_[3]});
            }
            const float zbias = bg[dir * 512 + h * 128 + 32 * zd + r];
            const __amdgpu_buffer_rsrc_t prs = __builtin_amdgcn_make_buffer_rsrc((void*)proj, 0, (unsigned)((size_t)MTOK * GINP * 2), 0x00020000);
            const unsigned qvoff = (unsigned)((16 * seg * GINP + h * 128 + d) * 2), vvoff = (unsigned)((16 * seg * GINP + 1024 + h * 256 + 2 * d) * 2);
            f32x4 gna, gnb;
            { const float* grow = gbuf + (size_t)(b * SEQ + (dir ? NCH - 1 : 0) * CH + r) * 32 + dir * 16 + 8 * hh; gna = *(const f32x4*)grow; gnb = *(const f32x4*)(grow + 4); }
            for (int n = 0; n <= NCH; ++n) {
                if (n < NCH) {
                    const int tok0 = b * SEQ + (dir ? NCH - 1 - n : n) * CH;
                    LAS unsigned char* set = lds + (n & 1) * G2_SET;
                    const f32x4 ga = gna, gb = gnb;
                    const unsigned srow = (unsigned)tok0 * (unsigned)(GINP * 2);
                    unsigned short qv[16], kv[16];
#pragma unroll
                    for (int ii = 0; ii < 16; ++ii) { qv[ii] = __builtin_amdgcn_raw_buffer_load_b16(prs, qvoff, srow + (unsigned)(ii * GINP * 2), 0);
                                                       kv[ii] = __builtin_amdgcn_raw_buffer_load_b16(prs, qvoff + 1024u, srow + (unsigned)(ii * GINP * 2), 0); }
                    unsigned vw[16];
#pragma unroll
                    for (int ii = 0; ii < 16; ++ii) vw[ii] = __builtin_amdgcn_raw_buffer_load_b32(prs, vvoff, srow + (unsigned)(ii * GINP * 2), 0);
                    { const int n1 = n + 1 < NCH ? n + 1 : n; const float* grow = gbuf + (size_t)(b * SEQ + (dir ? NCH - 1 - n1 : n1) * CH + r) * 32 + dir * 16 + 8 * hh;
                      gna = *(const f32x4*)grow; gnb = *(const f32x4*)(grow + 4); }
                    {
                        u32x4 ah, al;
                        ah.x = pk2(ga[0], ga[1]); ah.y = pk2(ga[2], ga[3]); ah.z = pk2(gb[0], gb[1]); ah.w = pk2(gb[2], gb[3]);
                        al.x = pk2(ga[0] - bflo(ah.x), ga[1] - bfhi(ah.x)); al.y = pk2(ga[2] - bflo(ah.y), ga[3] - bfhi(ah.y));
                        al.z = pk2(gb[0] - bflo(ah.z), gb[1] - bfhi(ah.z)); al.w = pk2(gb[2] - bflo(ah.w), gb[3] - bfhi(ah.w));
                        const bf16x8 gah = __builtin_bit_cast(bf16x8, ah), gal = __builtin_bit_cast(bf16x8, al);
                        f32x16 zacc;
#pragma unroll
                        for (int i = 0; i < 16; ++i) zacc[i] = zbias;
                        zacc = MFMA32(gah, wbh, zacc); zacc = MFMA32(gal, wbh, zacc); zacc = MFMA32(gah, wbl, zacc);
#pragma unroll
                        for (int i = 0; i < 16; ++i) *(LAS float*)(lds + G2_Z + (((i & 3) + 8 * (i >> 2) + 4 * hh) * 128 + 32 * zd + r) * 4) = zacc[i];
                    }
                    G2_BAR();
                    float cs[16];
#pragma unroll
                    for (int ii = 0; ii < 16; ++ii) {
                        const float z = *(const LAS float*)(lds + G2_Z + ((16 * seg + ii) * 128 + d) * 4);
                        cs[ii] = fminf(z, 0.f) * (1.4426950408889634f / 16.f) - __builtin_amdgcn_logf(1.f + __builtin_amdgcn_exp2f(fabsf(z) * -1.4426950408889634f)) * (1.f / 16.f);
                    }
                    if (dir == 0) {
#pragma unroll
                        for (int ii = 1; ii < 16; ++ii) cs[ii] += cs[ii - 1];
                        *(LAS float*)(lds + G2_SEG + (seg * 128 + d) * 4) = cs[15];
                    } else {
#pragma unroll
                        for (int ii = 14; ii >= 0; --ii) cs[ii] += cs[ii + 1];
                        *(LAS float*)(lds + G2_SEG + (seg * 128 + d) * 4) = cs[0];
                    }
                    G2_BAR();
                    {
                        const float t0 = *(const LAS float*)(lds + G2_SEG + d * 4), t1 = *(const LAS float*)(lds + G2_SEG + (128 + d) * 4);
                        const float prefix = dir == 0 ? (seg ? t0 : 0.f) : (seg ? 0.f : t1);
                        const float ebl = __builtin_amdgcn_exp2f(t0 + t1);
                        unsigned kd[8];
#pragma unroll
                        for (int ii = 0; ii < 16; ii += 2) {
                            const float e0 = __builtin_amdgcn_exp2f(prefix + cs[ii]), e1 = __builtin_amdgcn_exp2f(prefix + cs[ii + 1]);
                            const float q0 = bf2f(qv[ii]), q1 = bf2f(qv[ii + 1]);
                            const float k0 = bf2f(kv[ii]) * __builtin_amdgcn_rcpf(e0), k1 = bf2f(kv[ii + 1]) * __builtin_amdgcn_rcpf(e1);
                            const unsigned qd = pk2(q0 * e0, q1 * e1);
                            const unsigned ki = pk2(k0, k1);
                            kd[ii >> 1] = pk2(k0 * ebl, k1 * ebl);
                            const int i0 = 16 * seg + ii;
                            *(LAS unsigned short*)(set + G2_QD + i0 * 272 + d * 2) = (unsigned short)(qd & 0xffffu);
                            *(LAS unsigned short*)(set + G2_QD + (i0 + 1) * 272 + d * 2) = (unsigned short)(qd >> 16);
                            *(LAS unsigned short*)(lds + G2_KI + i0 * 272 + d * 2) = (unsigned short)(ki & 0xffffu);
                            *(LAS unsigned short*)(lds + G2_KI + (i0 + 1) * 272 + d * 2) = (unsigned short)(ki >> 16);
                        }
                        *(LAS u32x4*)(set + G2_KDT + d * 80 + seg * 32) = (u32x4){kd[0], kd[1], kd[2], kd[3]};
                        *(LAS u32x4*)(set + G2_KDT + d * 80 + seg * 32 + 16) = (u32x4){kd[4], kd[5], kd[6], kd[7]};
                        if (seg == 0) *(LAS float*)(set + G2_EBL + d * 4) = ebl;
                        unsigned c0[8], c1[8];
#pragma unroll
                        for (int t = 0; t < 8; ++t) { const unsigned a_ = vw[2 * t], b_ = vw[2 * t + 1]; c0[t] = (a_ & 0xffffu) | (b_ << 16); c1[t] = (a_ >> 16) | (b_ & 0xffff0000u); }
                        *(LAS u32x4*)(set + G2_VT + (2 * d) * 80 + seg * 32) = (u32x4){c0[0], c0[1], c0[2], c0[3]};
                        *(LAS u32x4*)(set + G2_VT + (2 * d) * 80 + seg * 32 + 16) = (u32x4){c0[4], c0[5], c0[6], c0[7]};
                        *(LAS u32x4*)(set + G2_VT + (2 * d + 1) * 80 + seg * 32) = (u32x4){c1[0], c1[1], c1[2], c1[3]};
                        *(LAS u32x4*)(set + G2_VT + (2 * d + 1) * 80 + seg * 32 + 16) = (u32x4){c1[4], c1[5], c1[6], c1[7]};
                    }
                    G2_BAR();
                    {
                        const int ti = wave >> 1, tj = wave & 1;
                        f32x4 a4 = (f32x4){0.f, 0.f, 0.f, 0.f};
#pragma unroll
                        for (int ks = 0; ks < 4; ++ks) {
                            const bf16x8 ka = *(const LAS bf16x8*)(lds + G2_KI + (16 * tj + fr) * 272 + ks * 64 + fq * 16);
                            const bf16x8 qb = *(const LAS bf16x8*)(set + G2_QD + (16 * ti + fr) * 272 + ks * 64 + fq * 16);
                            a4 = MFMA16(ka, qb, a4);
                        }
                        const int qi = 16 * ti + fr, kj = 16 * tj + 4 * fq;
                        float m[4];
#pragma unroll
                        for (int e = 0; e < 4; ++e) { const bool keep = dir ? (kj + e > qi) : (kj + e <= qi); m[e] = keep ? a4[e] : 0.f; }
                        u32x2 w; w.x = pk2(m[0], m[1]); w.y = pk2(m[2], m[3]);
                        *(LAS u32x2*)(set + G2_SC + qi * 80 + kj * 2) = w;
                    }
                    G2_BAR();
                } else { G2_BAR(); G2_BAR(); G2_BAR(); G2_BAR(); }
            }
        } else {
            const int cw = wave - 4;
            bf16_t* ob = dir ? ob1 : ob0;
            const __amdgpu_buffer_rsrc_t ors = __builtin_amdgcn_make_buffer_rsrc((void*)ob, 0, (unsigned)((size_t)MTOK * DM * 2), 0x00020000);
            const unsigned ovoff = (unsigned)((r * DM + h * 256 + 64 * cw + 4 * hh) * 2);
            f32x16 S[2][4];
#pragma unroll
            for (int nt2 = 0; nt2 < 2; ++nt2)
#pragma unroll
                for (int kt = 0; kt < 4; ++kt)
#pragma unroll
                    for (int i = 0; i < 16; ++i) S[nt2][kt][i] = 0.f;
            for (int n = 0; n <= NCH; ++n) {
                if (n >= 1) {
                    const int mch = n - 1;
                    const int tok0 = b * SEQ + (dir ? NCH - 1 - mch : mch) * CH;
                    const LAS unsigned char* set = lds + (mch & 1) * G2_SET;
                    bf16x8 bv[2][2];
#pragma unroll
                    for (int nt2 = 0; nt2 < 2; ++nt2)
#pragma unroll
                        for (int ks = 0; ks < 2; ++ks) bv[nt2][ks] = *(const LAS bf16x8*)(set + G2_VT + (64 * cw + 32 * nt2 + r) * 80 + ks * 32 + hh * 16);
                    f32x16 oacc[2];
#pragma unroll
                    for (int nt2 = 0; nt2 < 2; ++nt2)
#pragma unroll
                        for (int i = 0; i < 16; ++i) oacc[nt2][i] = 0.f;
#pragma unroll
                    for (int ks = 0; ks < 2; ++ks) {
                        const bf16x8 a = *(const LAS bf16x8*)(set + G2_SC + r * 80 + ks * 32 + hh * 16);
#pragma unroll
                        for (int nt2 = 0; nt2 < 2; ++nt2) oacc[nt2] = MFMA32(bv[nt2][ks], a, oacc[nt2]);
                    }
#define G2_OINTER(KT) do { _Pragma("unroll") for (int s = 0; s < 2; ++s) { __builtin_amdgcn_sched_barrier(0); \
                        const s16x4 lo = *(const LAS s16x4*)(set + G2_QD + r * 272 + (KT) * 64 + s * 32 + hh * 8); \
                        const s16x4 hi = *(const LAS s16x4*)(set + G2_QD + r * 272 + (KT) * 64 + s * 32 + hh * 8 + 16); \
                        const bf16x8 a = __builtin_shufflevector(lo, hi, 0, 1, 2, 3, 4, 5, 6, 7); \
                        _Pragma("unroll") for (int nt2 = 0; nt2 < 2; ++nt2) { u32x4 sp; \
                            sp.x = pk2(S[nt2][KT][8 * s + 0], S[nt2][KT][8 * s + 1]); sp.y = pk2(S[nt2][KT][8 * s + 2], S[nt2][KT][8 * s + 3]); \
                            sp.z = pk2(S[nt2][KT][8 * s + 4], S[nt2][KT][8 * s + 5]); sp.w = pk2(S[nt2][KT][8 * s + 6], S[nt2][KT][8 * s + 7]); \
                            oacc[nt2] = MFMA32(__builtin_bit_cast(bf16x8, sp), a, oacc[nt2]); } } } while (0)
                    G2_OINTER(0);
                    G2_BAR();
                    G2_OINTER(1); G2_OINTER(2);
                    G2_BAR();
                    G2_OINTER(3);
                    {
                        const unsigned orow = (unsigned)tok0 * (unsigned)(DM * 2);
#pragma unroll
                        for (int nt2 = 0; nt2 < 2; ++nt2)
#pragma unroll
                            for (int g = 0; g < 4; ++g) {
                                u32x2 w; w.x = pk2(oacc[nt2][4 * g], oacc[nt2][4 * g + 1]); w.y = pk2(oacc[nt2][4 * g + 2], oacc[nt2][4 * g + 3]);
                                __builtin_amdgcn_raw_buffer_store_b64(w, ors, ovoff + (unsigned)((32 * nt2 + 8 * g) * 2), orow, 0);
                            }
                    }
#define G2_STATE(KT) do { \
                        _Pragma("unroll") for (int g4 = 0; g4 < 4; ++g4) { const f32x4 e4 = *(const LAS f32x4*)(set + G2_EBL + (32 * (KT) + 8 * g4 + 4 * hh) * 4); \
                            _Pragma("unroll") for (int nt2 = 0; nt2 < 2; ++nt2) _Pragma("unroll") for (int e = 0; e < 4; ++e) S[nt2][KT][4 * g4 + e] *= e4[e]; } \
                        _Pragma("unroll") for (int ks = 0; ks < 2; ++ks) { const bf16x8 a = *(const LAS bf16x8*)(set + G2_KDT + (32 * (KT) + r) * 80 + ks * 32 + hh * 16); \
                            _Pragma("unroll") for (int nt2 = 0; nt2 < 2; ++nt2) S[nt2][KT] = MFMA32(a, bv[nt2][ks], S[nt2][KT]); } } while (0)
                    G2_STATE(0); G2_STATE(1);
                    G2_BAR();
                    G2_STATE(2); G2_STATE(3);
#undef G2_STATE
                    G2_BAR();
#undef G2_OINTER
                } else { G2_BAR(); G2_BAR(); G2_BAR(); G2_BAR(); }
            }
        }
        G2_BAR();
    }
}

__device__ __forceinline__ void gla_post_phase(const bf16_t* ob0, const bf16_t* ob1, const bf16_t* proj, const float* hgain, bf16_t* a2) {
    int tid = threadIdx.x; asm volatile("" : "+v"(tid));
    const int lane = tid & 63, wave = __builtin_amdgcn_readfirstlane(tid >> 6);
    const int gw = blockIdx.x * NWAVES + wave, NGW = gridDim.x * NWAVES;
    const int hp = lane >> 5, c8 = (lane & 31) * 8;
    const f32x4 hg0 = *(const f32x4*)(hgain + c8), hg1 = *(const f32x4*)(hgain + c8 + 4);
    u32x4 a[2], b[2], rr[2], na[2], nb[2], nr[2];
#define POST_LOAD(A_, B_, R_, row_) do { _Pragma("unroll") for (int ps = 0; ps < 2; ++ps) { const size_t off_ = (size_t)(row_) * DM + (2 * ps + hp) * 256 + c8; \
        A_[ps] = *(const u32x4*)(ob0 + off_); B_[ps] = *(const u32x4*)(ob1 + off_); R_[ps] = *(const u32x4*)(proj + (size_t)(row_) * GINP + 2048 + (2 * ps + hp) * 256 + c8); } } while (0)
    if (gw < MTOK) POST_LOAD(a, b, rr, gw);
    if (gw + NGW < MTOK) POST_LOAD(na, nb, nr, gw + NGW);
    for (int row = gw; row < MTOK; row += NGW) {
        u32x4 ca[2], cb[2], cr[2];
#pragma unroll
        for (int ps = 0; ps < 2; ++ps) { ca[ps] = a[ps]; cb[ps] = b[ps]; cr[ps] = rr[ps]; a[ps] = na[ps]; b[ps] = nb[ps]; rr[ps] = nr[ps]; }
        if (row + 2 * NGW < MTOK) POST_LOAD(na, nb, nr, row + 2 * NGW);
#pragma unroll
        for (int ps = 0; ps < 2; ++ps) {
            float o[8];
#pragma unroll
            for (int q = 0; q < 4; ++q) { o[2 * q] = bflo(ca[ps][q]) + bflo(cb[ps][q]); o[2 * q + 1] = bfhi(ca[ps][q]) + bfhi(cb[ps][q]); }
            float ss = 0.f;
#pragma unroll
            for (int q = 0; q < 8; ++q) ss += o[q] * o[q];
#pragma unroll
            for (int sh = 1; sh < 32; sh <<= 1) ss += __shfl_xor(ss, sh);
            const float rs = rsqrtf(ss * (1.f / 256.f) + EPS);
            u32x4 w;
            w.x = pk2(o[0] * rs * hg0[0] * silu_f(bflo(cr[ps].x)), o[1] * rs * hg0[1] * silu_f(bfhi(cr[ps].x)));
            w.y = pk2(o[2] * rs * hg0[2] * silu_f(bflo(cr[ps].y)), o[3] * rs * hg0[3] * silu_f(bfhi(cr[ps].y)));
            w.z = pk2(o[4] * rs * hg1[0] * silu_f(bflo(cr[ps].z)), o[5] * rs * hg1[1] * silu_f(bfhi(cr[ps].z)));
            w.w = pk2(o[6] * rs * hg1[2] * silu_f(bflo(cr[ps].w)), o[7] * rs * hg1[3] * silu_f(bfhi(cr[ps].w)));
            *(u32x4*)(a2 + (size_t)row * DM + (2 * ps + hp) * 256 + c8) = w;
        }
    }
#undef POST_LOAD
}

__device__ __forceinline__ void final_norm_phase(float* out, const bf16_t* xb, const float* ssq, const float* gain) {
    int tid = threadIdx.x; asm volatile("" : "+v"(tid));
    const int lane = tid & 63, wave = __builtin_amdgcn_readfirstlane(tid >> 6);
    const int gw = blockIdx.x * NWAVES + wave, NGW = gridDim.x * NWAVES;
    f32x4 g[4];
#pragma unroll
    for (int j = 0; j < 2; ++j) { g[2 * j] = *(const f32x4*)(gain + 512 * j + 8 * lane); g[2 * j + 1] = *(const f32x4*)(gain + 512 * j + 8 * lane + 4); }
    u32x4 w[2], nw[2]; f32x4 sq, nsq;
#define FIN_LOAD(W_, S_, row_) do { W_[0] = *(const u32x4*)(xb + (size_t)(row_) * DM + 8 * lane); W_[1] = *(const u32x4*)(xb + (size_t)(row_) * DM + 512 + 8 * lane); S_ = *(const f32x4*)(ssq + (size_t)(row_) * 4); } while (0)
    if (gw < MTOK) FIN_LOAD(w, sq, gw);
    if (gw + NGW < MTOK) FIN_LOAD(nw, nsq, gw + NGW);
    for (int row = gw; row < MTOK; row += NGW) {
        const u32x4 c0 = w[0], c1 = w[1]; const float rs = rsqrtf(((sq.x + sq.y) + (sq.z + sq.w)) * (1.f / 1024.f) + EPS);
        w[0] = nw[0]; w[1] = nw[1]; sq = nsq;
        if (row + 2 * NGW < MTOK) FIN_LOAD(nw, nsq, row + 2 * NGW);
        float* orow = out + (size_t)row * DM + 8 * lane;
        *(f32x4*)(orow) = (f32x4){bflo(c0.x), bfhi(c0.x), bflo(c0.y), bfhi(c0.y)} * rs * g[0];
        *(f32x4*)(orow + 4) = (f32x4){bflo(c0.z), bfhi(c0.z), bflo(c0.w), bfhi(c0.w)} * rs * g[1];
        *(f32x4*)(orow + 512) = (f32x4){bflo(c1.x), bfhi(c1.x), bflo(c1.y), bfhi(c1.y)} * rs * g[2];
        *(f32x4*)(orow + 516) = (f32x4){bflo(c1.z), bfhi(c1.z), bflo(c1.w), bfhi(c1.w)} * rs * g[3];
    }
#undef FIN_LOAD
}

#define XB_TMO      128
#define XB_XCNT(j)  (256  + 64 * (j))
#define XB_XSUB(j)  (1280 + 64 * (j))
#define XB_XGEN(j)  (2304 + 64 * (j))
#define XB_TOP      3328
#define XB_TOPGEN   3392
#define XCD_BAR_WORDS 3456
#define XB_SPIN_CAP (1u << 22)
__device__ __forceinline__ unsigned xb_ld(unsigned* p)              { return __hip_atomic_load(p, __ATOMIC_RELAXED, __HIP_MEMORY_SCOPE_AGENT); }
__device__ __forceinline__ unsigned xb_add(unsigned* p, unsigned v) { return __hip_atomic_fetch_add(p, v, __ATOMIC_RELAXED, __HIP_MEMORY_SCOPE_AGENT); }
__device__ __forceinline__ unsigned xb_xcc_id() { return (unsigned)__builtin_amdgcn_s_getreg((3 << 11) | 20) & 0xFu; }
#define XB_SPIN(cond, bar) do { unsigned _sp = 0; while (cond) { __builtin_amdgcn_s_sleep(1); \
    if ((++_sp & 255u) == 0u) { if (xb_ld(&(bar)[XB_TMO])) break; if (_sp > XB_SPIN_CAP) { atomicAdd(&(bar)[XB_TMO], 1u); break; } } } } while (0)
struct XcdBarrier { unsigned* bar; unsigned x; volatile LAS unsigned* st; };
__device__ __forceinline__ XcdBarrier xcd_barrier_post(unsigned* bar, volatile LAS unsigned* st) {
    XcdBarrier b; b.bar = bar; b.x = xb_xcc_id(); b.st = st;
    if (threadIdx.x == 0) (void)xb_add(&bar[XB_XCNT(b.x)], 1u);
    return b;
}
__device__ __forceinline__ void xcd_barrier_complete(unsigned* bar, unsigned x, unsigned& nloc, unsigned& nx) {
    const unsigned G = gridDim.x * gridDim.y * gridDim.z;
    unsigned sum, cnt, mine, sp = 0u;
    for (;;) {
        sum = 0u; cnt = 0u; mine = 0u;
#pragma unroll
        for (unsigned j = 0; j < 16; ++j) { const unsigned c = xb_ld(&bar[XB_XCNT(j)]); sum += c; cnt += (c > 0u) ? 1u : 0u; mine = (j == x) ? c : mine; }
        if (sum == G) break;
        __builtin_amdgcn_s_sleep(1);
        if ((++sp & 255u) == 0u) { if (xb_ld(&bar[XB_TMO])) break; if (sp > XB_SPIN_CAP) { atomicAdd(&bar[XB_TMO], 1u); break; } }
    }
    nloc = mine > 0u ? mine : 1u; nx = cnt > 0u ? cnt : 1u;
}
__device__ __forceinline__ void xcd_barrier(const XcdBarrier& b) {
    asm volatile("s_waitcnt vmcnt(0)" ::: "memory");
    __syncthreads();
    if (threadIdx.x == 0) {
        unsigned* bar = b.bar;
        __builtin_amdgcn_s_waitcnt(0);
        unsigned nloc = b.st[0], nx = b.st[1];
        if (nloc == 0u) { xcd_barrier_complete(bar, b.x, nloc, nx); b.st[0] = nloc; b.st[1] = nx; }
        const unsigned old = xb_add(&bar[XB_XSUB(b.x)], 1u);
        const unsigned gen = old / nloc;
        if (old + 1u == (gen + 1u) * nloc) {
            __builtin_amdgcn_fence(__ATOMIC_RELEASE, "agent");
            asm volatile("s_waitcnt vmcnt(0)" ::: "memory");
            const unsigned og = xb_add(&bar[XB_TOP], 1u);
            const unsigned tg = og / nx;
            if (og + 1u == (tg + 1u) * nx) xb_add(&bar[XB_TOPGEN], 1u);
            else XB_SPIN(xb_ld(&bar[XB_TOPGEN]) == tg, bar);
            __builtin_amdgcn_fence(__ATOMIC_ACQUIRE, "agent");
            xb_add(&bar[XB_XGEN(b.x)], 1u);
            asm volatile("s_waitcnt vmcnt(0)" ::: "memory");
        } else {
            XB_SPIN(xb_ld(&bar[XB_XGEN(b.x)]) == gen, bar);
            __builtin_amdgcn_fence(__ATOMIC_ACQUIRE, "agent");
            asm volatile("s_waitcnt vmcnt(0)" ::: "memory");
        }
    }
    __syncthreads();
}

__device__ __forceinline__ void rstd_cache_reset(LAS unsigned char* lds) {
    int tid = threadIdx.x; asm volatile("" : "+v"(tid));
    if (tid < 4) ((volatile LAS int*)(lds + pg8::STAGE_BYTES + 8208))[tid] = -1;
    __syncthreads();
}
__global__ void __launch_bounds__(NTHREADS, 2) fwd_megakernel(Params p) {
    extern __shared__ __attribute__((aligned(16))) unsigned char lds_raw[];
    LAS unsigned char* lds = (LAS unsigned char*)lds_raw;
    cg::grid_group grid = cg::this_grid();
    const int G = gridDim.x, bx = blockIdx.x;
    unsigned char* ws = p.ws;
    float* ssq = (float*)(ws + WS_SSQ);
    float* gbuf = (float*)(ws + WS_GBUF);
    bf16_t* XB = (bf16_t*)(ws + WS_XB);
    bf16_t* R2 = (bf16_t*)(ws + WS_R2);
    bf16_t* OB1 = (bf16_t*)(ws + WS_OB1);
    bf16_t* OB0 = (bf16_t*)p.out;
    bf16_t* R1 = (bf16_t*)(ws + WS_R1);
    if (threadIdx.x < 2) ((volatile LAS unsigned*)(lds + 139264))[threadIdx.x] = 0u;
    __syncthreads();
    const XcdBarrier xbar = xcd_barrier_post((unsigned*)ws, (volatile LAS unsigned*)(lds + 139264));
#define GRID_SYNC() xcd_barrier(xbar)

    p0_phase(p, lds);
    grid.sync();

#pragma unroll 1
    for (int layer = 0; layer < 4; ++layer) {
        const int j = layer >> 1;
        if ((layer & 1) == 0) {
            pool_prep_phase(lds, XB, ssq, p.norm_mix + layer * DM, R2);
            GRID_SYNC();
            { pg8::Gemm g{R2, (const bf16_t*)(ws + WS_WPOOL + j * SZ_WPOOL), 256, DM, 256, 256}; pg8::StaticOrder S; S.init(MTOK, DM, G, bx);
              pg8::EpiRes E{XB, XB, ssq};
              pg8::gemm_phase<pg8::EpiRes, pg8::StaticOrder>(lds, g, S, E); }
            GRID_SYNC();
        } else {
            rstd_cache_reset(lds);
            { pg8::Gemm g{XB, (const bf16_t*)(ws + WS_WIN + j * SZ_WIN), DM, DM, DM, 0}; pg8::StaticOrder S; S.init(MTOK, GINP, G, bx);
              pg8::EpiProj E{R1, gbuf, ssq};
              pg8::gemm_phase<pg8::EpiProj, pg8::StaticOrder>(lds, g, S, E);
            }
            GRID_SYNC();
            gla_scan_phase2(lds, R1, gbuf, p.w_gate_up + (size_t)j * 2 * 16 * 512, p.b_gate + (size_t)j * 2 * 512, OB0, OB1);
            GRID_SYNC();
            gla_post_phase(OB0, OB1, R1, p.gla_head_norm + j * 256, R2);
            GRID_SYNC();
            { pg8::Gemm g{R2, (const bf16_t*)(ws + WS_WOUT + j * SZ_WOUT), DM, DM, DM, 0}; pg8::StaticOrder S; S.init(MTOK, DM, G, bx);
              pg8::EpiRes E{XB, XB, ssq};
              pg8::gemm_phase<pg8::EpiRes, pg8::StaticOrder>(lds, g, S, E); }
            GRID_SYNC();
        }
        rstd_cache_reset(lds);
        { pg8::Gemm g{XB, (const bf16_t*)(ws + WS_WGU + layer * SZ_WGU), DM, DM, DM, 0}; pg8::StaticOrder S; S.init(MTOK, NGU, G, bx);
          pg8::EpiGU E{R1, ssq};
          pg8::gemm_phase<pg8::EpiGU, pg8::StaticOrder>(lds, g, S, E);
        }
        GRID_SYNC();
        { pg8::Gemm g{R1, (const bf16_t*)(ws + WS_WD + layer * SZ_WD), DFF, DFF, DFF, 0}; pg8::StaticOrder S; S.init(MTOK, DM, G, bx); S.rev = (S.nwg % G) == 0;
          pg8::EpiRes E{XB, XB, ssq};
          pg8::gemm_phase<pg8::EpiRes, pg8::StaticOrder>(lds, g, S, E); }
        GRID_SYNC();
    }
    final_norm_phase(p.out, XB, ssq, p.norm_final);
}

extern "C" void kernel_launch(void* const* d_in, const int* in_sizes, int n_in, void* d_out, int out_size, void* d_ws, size_t ws_size, hipStream_t stream) {
    static int grid = 0;
    if (grid == 0) {
        if (n_in != 14 || in_sizes[0] != MTOK * DM || out_size != MTOK * DM || ws_size < WS_END) {
            fprintf(stderr, "kernel_launch: unexpected shapes (n_in %d, in0 %d, out %d, ws %zu, need %zu); nothing launched\n", n_in, n_in > 0 ? in_sizes[0] : -1, out_size, ws_size, (size_t)WS_END);
            grid = -1; return;
        }
        int dev = 0, cus = 0, per_cu = 0;
        (void)hipGetDevice(&dev);
        (void)hipDeviceGetAttribute(&cus, hipDeviceAttributeMultiprocessorCount, dev);
        if (hipFuncSetAttribute((const void*)fwd_megakernel, hipFuncAttributeMaxDynamicSharedMemorySize, LDS_BYTES) != hipSuccess) { fprintf(stderr, "kernel_launch: hipFuncSetAttribute failed\n"); grid = -1; return; }
        if (hipOccupancyMaxActiveBlocksPerMultiprocessor(&per_cu, (const void*)fwd_megakernel, NTHREADS, LDS_BYTES) != hipSuccess || per_cu < 1) {
            fprintf(stderr, "kernel_launch: occupancy query says %d blocks per CU; using 1\n", per_cu); per_cu = 1; (void)hipGetLastError();
        }
        grid = cus * 1;
        fprintf(stderr, "kernel_launch: grid %d (cus %d, per_cu %d)\n", grid, cus, per_cu);
    }
    if (grid < 0) return;
    if (hipMemsetAsync(d_ws, 0, 16384, stream) != hipSuccess) { fprintf(stderr, "kernel_launch: memset failed\n"); return; }
    Params p{};
    p.x = (const float*)d_in[0]; p.norm_mix = (const float*)d_in[1]; p.norm_ffn = (const float*)d_in[2]; p.norm_final = (const float*)d_in[3];
    p.w_pool = (const float*)d_in[4]; p.pool_scale = (const float*)d_in[5]; p.w_gla_in = (const float*)d_in[6]; p.w_gate_up = (const float*)d_in[7];
    p.b_gate = (const float*)d_in[8]; p.gla_head_norm = (const float*)d_in[9]; p.w_gla_out = (const float*)d_in[10]; p.w_ffn_gate = (const float*)d_in[11];
    p.w_ffn_up = (const float*)d_in[12]; p.w_ffn_down = (const float*)d_in[13];
    p.out = (float*)d_out; p.ws = (unsigned char*)d_ws;
    void* args[] = {&p};
    hipError_t e = hipLaunchCooperativeKernel((const void*)fwd_megakernel, dim3(grid), dim3(NTHREADS), args, LDS_BYTES, stream);
    if (e != hipSuccess) fprintf(stderr, "kernel_launch: cooperative launch failed: %s (grid %d)\n", hipGetErrorString(e), grid);
}
```
